# Optimizing an MI355X kernel written in HIP

```python
import jax, jax.numpy as jnp
from jax import lax
import numpy as np

D_MODEL = 1024
BATCH = 8
SEQ = 2048
DEPTH = 4

ATT_HEADS = 16
ATT_KV_HEADS = 4
ATT_GROUP = ATT_HEADS // ATT_KV_HEADS
ATT_HEAD_DIM = 64
WINDOW = 128
DN_HEADS = 8
DN_HEAD_DIM = 128
CONV_K = 4
CHUNK = 64
D_FF = 4 * D_MODEL
ATT_Q_W = ATT_HEADS * ATT_HEAD_DIM
ATT_KV_W = ATT_KV_HEADS * ATT_HEAD_DIM
DN_W = DN_HEADS * DN_HEAD_DIM
IN_SPLITS = (ATT_Q_W, ATT_KV_W, ATT_KV_W, DN_W, DN_W, DN_W, DN_W, DN_HEADS, DN_HEADS, D_MODEL, D_MODEL)
D_IN = ATT_Q_W + 2 * ATT_KV_W + 4 * DN_W + 2 * DN_HEADS + 2 * D_MODEL
ALPHA = (2 * DEPTH) ** 0.25
BETA_INIT = (8 * DEPTH) ** -0.25
LN_EPS = 1e-5
RMS_EPS = 1e-6
ADA_SCALE = 0.2

kernel_name = "hybrid_swa_sink_gdn_parallel_deepnorm_adaln"


def _split_in(p):
    outs = []
    off = 0
    for w in IN_SPLITS:
        outs.append(p[..., off:off + w])
        off += w
    return outs


def _layer_norm(x, g, b):
    xf = x.astype(jnp.float32)
    mu = jnp.mean(xf, axis=-1, keepdims=True)
    var = jnp.mean(jnp.square(xf - mu), axis=-1, keepdims=True)
    return ((xf - mu) * lax.rsqrt(var + LN_EPS) * g.astype(jnp.float32) + b.astype(jnp.float32)).astype(x.dtype)


def _l2norm(t):
    return t * lax.rsqrt(jnp.sum(jnp.square(t), axis=-1, keepdims=True) + RMS_EPS)


def _causal_conv_silu(x, w):
    s = x.shape[1]
    xp = jnp.pad(x, ((0, 0), (CONV_K - 1, 0), (0, 0)))
    y = sum(xp[:, j:j + s] * w[j] for j in range(CONV_K))
    return jax.nn.silu(y)


def _sliding_window_attention(q, k, v, sinks):
    b, s, _ = q.shape
    nb = s // WINDOW
    qb = q.reshape(b, nb, WINDOW, ATT_KV_HEADS, ATT_GROUP, ATT_HEAD_DIM)

    def band(t):
        tp = jnp.pad(t, ((0, 0), (WINDOW, 0), (0, 0)))
        tb = tp.reshape(b, nb + 1, WINDOW, ATT_KV_HEADS, ATT_HEAD_DIM)
        return jnp.concatenate([tb[:, :-1], tb[:, 1:]], axis=2)

    kb, vb = band(k), band(v)
    scores = jnp.einsum('bnqhgd,bnshd->bnhgqs', qb, kb).astype(jnp.float32) * (ATT_HEAD_DIM ** -0.5)
    qi = jnp.arange(WINDOW)[:, None]
    si = jnp.arange(2 * WINDOW)[None, :]
    diff = qi + WINDOW - si
    blk = jnp.arange(nb)[:, None, None]
    valid = (diff >= 0) & (diff < WINDOW) & (blk * WINDOW + si - WINDOW >= 0)
    scores = jnp.where(valid[None, :, None, None], scores, -jnp.inf)
    sink = sinks.astype(jnp.float32).reshape(1, 1, ATT_KV_HEADS, ATT_GROUP, 1, 1)
    m = jnp.maximum(jnp.max(scores, axis=-1, keepdims=True), sink)
    p = jnp.exp(scores - m)
    denom = jnp.sum(p, axis=-1, keepdims=True) + jnp.exp(sink - m)
    probs = (p / denom).astype(v.dtype)
    o = jnp.einsum('bnhgqs,bnshd->bnqhgd', probs, vb)
    return o.reshape(b, s, ATT_Q_W)


def _gated_delta_rule(q, k, v, beta, g):
    b, s, h, d = q.shape
    n = s // CHUNK

    def chunks(t):
        t = t.reshape((b, n, CHUNK, h) + t.shape[3:])
        return jnp.moveaxis(t, 3, 1)

    q, k, v, beta, g = (chunks(t) for t in (q, k, v, beta, g))
    g_cum = jnp.cumsum(g, axis=-1)
    causal = jnp.tril(jnp.ones((CHUNK, CHUNK), dtype=bool))
    strict = jnp.tril(jnp.ones((CHUNK, CHUNK), dtype=bool), -1)
    decay = jnp.exp(jnp.where(causal, g_cum[..., :, None] - g_cum[..., None, :], -jnp.inf))
    kb = k * beta[..., None]
    vb = v * beta[..., None]
    l_mat = jnp.where(strict, jnp.einsum('bhncd,bhnsd->bhncs', kb, k) * decay, 0.0)
    a_mat = l_mat + jnp.eye(CHUNK, dtype=l_mat.dtype)
    rhs = jnp.concatenate([vb, kb * jnp.exp(g_cum)[..., None]], axis=-1)
    sol = lax.linalg.triangular_solve(a_mat, rhs, left_side=True, lower=True, unit_diagonal=True)
    u, w = sol[..., :d], sol[..., d:]
    intra = jnp.einsum('bhncd,bhnsd->bhncs', q, k) * decay
    q_dec = q * jnp.exp(g_cum)[..., None]
    k_dec = k * jnp.exp(g_cum[..., -1:] - g_cum)[..., None]
    last = jnp.exp(g_cum[..., -1])
    xs = tuple(jnp.moveaxis(t, 2, 0) for t in (u, w, intra, q_dec, k_dec, last))

    def step(state, inp):
        u_c, w_c, intra_c, q_c, k_c, last_c = inp
        v_new = u_c - jnp.einsum('bhck,bhkv->bhcv', w_c, state)
        o_c = jnp.einsum('bhck,bhkv->bhcv', q_c, state) + jnp.einsum('bhcs,bhsv->bhcv', intra_c, v_new)
        state = state * last_c[..., None, None] + jnp.einsum('bhck,bhcv->bhkv', k_c, v_new)
        return state, o_c

    s0 = jnp.zeros((b, h, d, d), jnp.float32)
    _, o = lax.scan(step, s0, xs)
    return jnp.transpose(o, (1, 0, 3, 2, 4)).reshape(b, s, h, d)


def _gated_deltanet(dq, dk, dv, z, b_raw, a_raw, conv_w, a_log, dt_bias, norm_w):
    bsz, s, _ = dq.shape
    qkv = _causal_conv_silu(jnp.concatenate([dq, dk, dv], axis=-1), conv_w)
    shp = (bsz, s, DN_HEADS, DN_HEAD_DIM)
    q = _l2norm(qkv[..., :DN_W].reshape(shp).astype(jnp.float32)) * (DN_HEAD_DIM ** -0.5)
    k = _l2norm(qkv[..., DN_W:2 * DN_W].reshape(shp).astype(jnp.float32))
    v = qkv[..., 2 * DN_W:].reshape(shp).astype(jnp.float32)
    beta = jax.nn.sigmoid(b_raw.astype(jnp.float32))
    g = -jnp.exp(a_log.astype(jnp.float32)) * jax.nn.softplus(a_raw.astype(jnp.float32) + dt_bias.astype(jnp.float32))
    o = _gated_delta_rule(q, k, v, beta, g)
    o = o * lax.rsqrt(jnp.mean(jnp.square(o), axis=-1, keepdims=True) + RMS_EPS) * norm_w.astype(jnp.float32)
    o = o * jax.nn.silu(z.reshape(shp).astype(jnp.float32))
    return o.reshape(bsz, s, DN_W).astype(dq.dtype)


def setup_inputs(seed: int = 0) -> dict:
    key = jax.random.key(seed)
    ks = jax.random.split(key, 24)
    nrm = jax.random.normal
    L, D = DEPTH, D_MODEL
    dt = jnp.exp(jax.random.uniform(ks[8], (L, DN_HEADS), minval=np.log(1e-3), maxval=np.log(1e-1)))
    return {
        "x": nrm(ks[0], (BATCH, SEQ, D), jnp.float32),
        "c": nrm(ks[1], (BATCH, D), jnp.float32),
        "w_ada": nrm(ks[2], (L, D, 6 * D), jnp.float32) * (ADA_SCALE * D ** -0.5),
        "b_ada": nrm(ks[3], (L, 6 * D), jnp.float32) * 0.01,
        "w_in": nrm(ks[4], (L, D, D_IN), jnp.float32) * D ** -0.5,
        "conv_w": nrm(ks[5], (L, CONV_K, 3 * DN_W), jnp.float32) * CONV_K ** -0.5,
        "a_log": jnp.log(jax.random.uniform(ks[6], (L, DN_HEADS), minval=1.0, maxval=16.0)),
        "dt_bias": dt + jnp.log(-jnp.expm1(-dt)),
        "sinks": nrm(ks[7], (L, ATT_HEADS), jnp.float32),
        "dn_norm_w": 1.0 + 0.02 * nrm(ks[9], (L, DN_HEAD_DIM), jnp.float32),
        "w_oa": nrm(ks[10], (L, ATT_Q_W, D), jnp.float32) * ATT_Q_W ** -0.5,
        "w_ob": nrm(ks[11], (L, DN_W, D), jnp.float32) * DN_W ** -0.5,
        "w_out": nrm(ks[12], (L, D, D), jnp.float32) * (BETA_INIT * D ** -0.5),
        "ln1_g": 1.0 + 0.02 * nrm(ks[13], (L, D), jnp.float32),
        "ln1_b": 0.02 * nrm(ks[14], (L, D), jnp.float32),
        "w_ff1": nrm(ks[15], (L, D, D_FF), jnp.float32) * D ** -0.5,
        "b_ff1": 0.02 * nrm(ks[16], (L, D_FF), jnp.float32),
        "w_ff2": nrm(ks[17], (L, D_FF, D), jnp.float32) * (BETA_INIT * D_FF ** -0.5),
        "b_ff2": 0.02 * nrm(ks[18], (L, D), jnp.float32),
        "ln2_g": 1.0 + 0.02 * nrm(ks[19], (L, D), jnp.float32),
        "ln2_b": 0.02 * nrm(ks[20], (L, D), jnp.float32),
    }


def reference(x, c, w_ada, b_ada, w_in, conv_w, a_log, dt_bias, sinks, dn_norm_w, w_oa, w_ob, w_out,
              ln1_g, ln1_b, w_ff1, b_ff1, w_ff2, b_ff2, ln2_g, ln2_b):
    c_act = jax.nn.silu(c)
    for l in range(DEPTH):
        mod = c_act @ w_ada[l] + b_ada[l]
        sh1, sc1, gt1, sh2, sc2, gt2 = jnp.split(mod[:, None, :], 6, axis=-1)
        u = x * (1.0 + sc1) + sh1
        proj = u @ w_in[l]
        qa, ka, va, dq, dk, dv, z, b_raw, a_raw, g_a, g_b = _split_in(proj)
        y_a = _sliding_window_attention(qa, ka, va, sinks[l]) @ w_oa[l]
        y_b = _gated_deltanet(dq, dk, dv, z, b_raw, a_raw, conv_w[l], a_log[l], dt_bias[l], dn_norm_w[l]) @ w_ob[l]
        mixed = (jax.nn.sigmoid(g_a) * y_a + jax.nn.sigmoid(g_b) * y_b) @ w_out[l]
        x = _layer_norm(ALPHA * x + (1.0 + gt1) * mixed, ln1_g[l], ln1_b[l])
        u2 = x * (1.0 + sc2) + sh2
        h = jnp.square(jax.nn.relu(u2 @ w_ff1[l] + b_ff1[l]))
        x = _layer_norm(ALPHA * x + (1.0 + gt2) * (h @ w_ff2[l] + b_ff2[l]), ln2_g[l], ln2_b[l])
    return x
```

```cpp
#include <hip/hip_runtime.h>
#include <hip/hip_cooperative_groups.h>
#include <cstdio>
#include <cstdint>
namespace cg = cooperative_groups;
namespace pg8 {
#define PG8_LAS __attribute__((address_space(3)))
typedef unsigned short bf16_t;
typedef short bf16x8 __attribute__((ext_vector_type(8)));
typedef float f32x4 __attribute__((ext_vector_type(4)));
typedef unsigned u32x4 __attribute__((ext_vector_type(4)));
constexpr int BM = 256, BK = 64, HALF = 128, HTB = HALF * BK * 2  , STAGE_BYTES = 8 * HTB, NXCD = 8, WGM = 8;

__host__ __device__ __forceinline__ int lds_byte(int r, int c) { const int st = (r >> 4) * 2 + (c >> 5), rr = r & 15, cc = c & 31, ob = rr * 64 + cc * 2; return st * 1024 + (ob ^ (((ob >> 9) & 1) << 5)); }
__host__ __device__ __forceinline__ void stage_rc(int b, int& R, int& C) { const int st = b / 1024, sb = b % 1024, swz = sb ^ (((sb >> 9) & 1) << 5); R = (st >> 1) * 16 + swz / 64; C = (st & 1) * 32 + (swz % 64) / 2; }
__host__ __device__ __forceinline__ int perm32(int rho) { const int n = rho >> 4, i = rho & 15; return 8 * (i >> 2) + 4 * n + (i & 3); }

struct Unit { int pm, pn; };
struct Gemm { const bf16_t* A; const bf16_t* Bt; int M, N, K; };

struct StaticOrder {
    int nM, nN, nwg, G, c;
    __host__ __device__ void init(int M, int N, int G_, int c_) { nM = M / BM; nN = N / BM; nwg = nM * nN; G = G_; c = c_; }
    __host__ __device__ bool next(int i, Unit& u) const {
        const long L = (long)i * G + c; if (L >= nwg) return false;
        int wgid = (int)L; { const int q = nwg / NXCD, r = nwg % NXCD, xcd = wgid % NXCD, off = wgid / NXCD; wgid = (xcd < r ? xcd * (q + 1) : r * (q + 1) + (xcd - r) * q) + off; }
        const int nig = WGM * nN, gid = wgid / nig, fm = gid * WGM, gsz = (nM - fm) < WGM ? (nM - fm) : WGM;
        u.pm = fm + ((wgid % nig) % gsz); u.pn = (wgid % nig) / gsz; return true;
    }
    __device__ __forceinline__ void a_ready(const Unit&) const {}
    __device__ __forceinline__ void done(const Unit&) const {}
};

__device__ __forceinline__ unsigned cvt_pk_bf16(float lo, float hi) { unsigned r; asm volatile("v_cvt_pk_bf16_f32 %0, %1, %2" : "=v"(r) : "v"(lo), "v"(hi)); return r; }
typedef float f32x2 __attribute__((ext_vector_type(2)));
template <class Epi, class Sched, bool ALIGN_EPI = false, bool SP2 = false>
__device__ __forceinline__ void gemm_phase(PG8_LAS unsigned char* lds, const Gemm g, const Sched& S, const Epi& E) {
    int tid = threadIdx.x; asm volatile("" : "+v"(tid)); const int wid = __builtin_amdgcn_readfirstlane(tid >> 6), lane = tid & 63, wr = wid >> 2, wc = wid & 3, fr = lane & 15, fq = lane >> 4;
    const int K = g.K, nt = K / BK;
    unsigned voffA[2], voffB[2];
#pragma unroll
    for (int i = 0; i < 2; ++i) { int R, C; stage_rc(tid * 16 + i * 8192, R, C); const int Rb = Epi::PERM ? ((R & ~31) + perm32(R & 31)) : R;
        voffA[i] = (unsigned)(R * K + C) * 2u; voffB[i] = (unsigned)(Rb * K + C) * 2u; }
    const size_t kstep = (size_t)(BK * 2);
    const size_t hstep = (size_t)HALF * K * 2;
    const size_t tstep = 2 * hstep;
    const unsigned ldsw = (unsigned)wid * 1024u;
    const int aoff = lds_byte(wr * 64 + fr, fq * 8), boff = lds_byte(wc * 32 + fr, fq * 8);
#define PG8_SA(b, h) (((b) * 2 + (h)) * HTB)
#define PG8_SB(b, h) ((4 + (b) * 2 + (h)) * HTB)
#define PG8_STAGE(bufoff, gbase, voff) do { _Pragma("unroll") for (int _i = 0; _i < 2; ++_i) \
        __builtin_amdgcn_global_load_lds((const unsigned*)((const char*)(gbase) + (voff)[_i]), (PG8_LAS unsigned*)(lds + (bufoff) + ldsw + _i * 8192), 16, 0, 0); } while (0)
#define PG8_LDA(dst, b, h) do { _Pragma("unroll") for (int m = 0; m < 4; ++m) _Pragma("unroll") for (int k = 0; k < 2; ++k) dst[m][k] = *(const PG8_LAS bf16x8*)(lds + PG8_SA(b, h) + aoff + m * 2048 + k * 1024); } while (0)
#define PG8_LDB(dst, b, h) do { _Pragma("unroll") for (int n = 0; n < 2; ++n) _Pragma("unroll") for (int k = 0; k < 2; ++k) dst[n][k] = *(const PG8_LAS bf16x8*)(lds + PG8_SB(b, h) + boff + n * 2048 + k * 1024); } while (0)
#define PG8_MMA(ai, bj, At, Bt) do { __builtin_amdgcn_s_setprio(1); _Pragma("unroll") for (int m = 0; m < 4; ++m) _Pragma("unroll") for (int n = 0; n < 2; ++n) _Pragma("unroll") for (int k = 0; k < 2; ++k) \
        acc[ai][bj][m][n] = __builtin_amdgcn_mfma_f32_16x16x32_bf16(Bt[n][k], At[m][k], acc[ai][bj][m][n], 0, 0, 0); __builtin_amdgcn_s_setprio(0); } while (0)
#define PG8_WAIT_V(n) asm volatile("s_waitcnt vmcnt(" #n ")" ::: "memory")
#define PG8_WAIT_L(n) asm volatile("s_waitcnt lgkmcnt(" #n ")" ::: "memory")
#define PG8_BAR __builtin_amdgcn_s_barrier()
#define PG8_SCHED __builtin_amdgcn_sched_barrier(0)
    Unit cur, nxt; int ui = 0;
    if (!S.next(0, cur)) return;
    f32x4 acc[2][2][4][2];
#pragma unroll
    for (int a = 0; a < 2; ++a)
#pragma unroll
        for (int b = 0; b < 2; ++b)
#pragma unroll
            for (int m = 0; m < 4; ++m)
#pragma unroll
                for (int n = 0; n < 2; ++n) acc[a][b][m][n] = (f32x4){0.f, 0.f, 0.f, 0.f};
    bf16x8 At[4][2], B0[2][2], B1[2][2];
    const char* cA = (const char*)g.A + (size_t)cur.pm * tstep; const char* cB = (const char*)g.Bt + (size_t)cur.pn * tstep;
    S.a_ready(cur);
    if constexpr (SP2) {
        PG8_STAGE(PG8_SB(0, 0), cB, voffB); PG8_STAGE(PG8_SB(0, 1), cB + hstep, voffB); PG8_STAGE(PG8_SA(0, 0), cA, voffA); PG8_STAGE(PG8_SA(0, 1), cA + hstep, voffA);
        if (wr == 1) PG8_BAR;
        PG8_WAIT_V(2); PG8_BAR;
        PG8_STAGE(PG8_SB(1, 0), cB + kstep, voffB); PG8_STAGE(PG8_SA(1, 0), cA + kstep, voffA); PG8_STAGE(PG8_SB(1, 1), cB + hstep + kstep, voffB);
        PG8_WAIT_V(6); PG8_BAR;
    } else {
        PG8_STAGE(PG8_SB(0, 0), cB, voffB); PG8_STAGE(PG8_SA(0, 0), cA, voffA); PG8_STAGE(PG8_SB(0, 1), cB + hstep, voffB); PG8_STAGE(PG8_SA(0, 1), cA + hstep, voffA);
        if (wr == 1) PG8_BAR;
        PG8_WAIT_V(4); PG8_BAR;
        PG8_STAGE(PG8_SB(1, 0), cB + kstep, voffB); PG8_STAGE(PG8_SA(1, 0), cA + kstep, voffA); PG8_STAGE(PG8_SB(1, 1), cB + hstep + kstep, voffB);
        PG8_WAIT_V(6); PG8_BAR;
    }
    for (;;) {
        const bool has_next = S.next(ui + 1, nxt);
        const char* nA = has_next ? (const char*)g.A + (size_t)nxt.pm * tstep : cA; const char* nB = has_next ? (const char*)g.Bt + (size_t)nxt.pn * tstep : cB;
        for (int t = 0; t < nt; t += 2) {
            const bool last = (t == nt - 2);
            const char* a1 = cA + (size_t)(t + 1) * kstep;
            const char* a2 = last ? nA : cA + (size_t)(t + 2) * kstep; const char* b2 = last ? nB : cB + (size_t)(t + 2) * kstep;
            const char* a3 = a2 + kstep; const char* b3 = b2 + kstep;
            if (last && has_next) S.a_ready(nxt);
            if constexpr (SP2) {
            PG8_LDB(B0, 0, 0); PG8_LDB(B1, 0, 1); PG8_SCHED; PG8_LDA(At, 0, 0); PG8_STAGE(PG8_SA(1, 1), a1 + hstep, voffA);
            PG8_WAIT_V(8); PG8_WAIT_L(0); PG8_BAR; PG8_MMA(0, 0, At, B0); PG8_MMA(0, 1, At, B1); PG8_BAR; PG8_SCHED;
            PG8_LDA(At, 0, 1); PG8_STAGE(PG8_SB(0, 0), b2, voffB); PG8_STAGE(PG8_SB(0, 1), b2 + hstep, voffB); PG8_STAGE(PG8_SA(0, 0), a2, voffA);
            PG8_WAIT_V(8); PG8_WAIT_L(0); PG8_BAR; PG8_MMA(1, 0, At, B0); PG8_MMA(1, 1, At, B1); PG8_BAR; PG8_SCHED;
            PG8_LDB(B0, 1, 0); PG8_LDB(B1, 1, 1); PG8_SCHED; PG8_LDA(At, 1, 0); PG8_STAGE(PG8_SA(0, 1), a2 + hstep, voffA);
            PG8_WAIT_V(8); PG8_WAIT_L(0); PG8_BAR; PG8_MMA(0, 0, At, B0); PG8_MMA(0, 1, At, B1); PG8_BAR; PG8_SCHED;
            PG8_LDA(At, 1, 1); PG8_STAGE(PG8_SB(1, 0), b3, voffB); PG8_STAGE(PG8_SB(1, 1), b3 + hstep, voffB); PG8_STAGE(PG8_SA(1, 0), a3, voffA);
            PG8_WAIT_V(8); PG8_WAIT_L(0); PG8_BAR; PG8_MMA(1, 0, At, B0); PG8_MMA(1, 1, At, B1); PG8_BAR; PG8_SCHED;
            } else {
            PG8_LDB(B0, 0, 0); PG8_SCHED; PG8_LDA(At, 0, 0); PG8_STAGE(PG8_SA(1, 1), a1 + hstep, voffA);
            PG8_WAIT_L(8); PG8_BAR; PG8_WAIT_L(0); PG8_MMA(0, 0, At, B0); PG8_BAR; PG8_SCHED;
            PG8_LDB(B1, 0, 1); PG8_STAGE(PG8_SB(0, 0), b2, voffB);
            PG8_BAR; PG8_WAIT_L(0); PG8_MMA(0, 1, At, B1); PG8_BAR;
            PG8_LDA(At, 0, 1); PG8_STAGE(PG8_SA(0, 0), a2, voffA);
            PG8_BAR; PG8_WAIT_L(0); PG8_MMA(1, 0, At, B0); PG8_BAR; PG8_SCHED;
            PG8_STAGE(PG8_SB(0, 1), b2 + hstep, voffB);
            PG8_WAIT_V(6); PG8_BAR; PG8_MMA(1, 1, At, B1); PG8_BAR;
            PG8_LDB(B0, 1, 0); PG8_SCHED; PG8_LDA(At, 1, 0); PG8_STAGE(PG8_SA(0, 1), a2 + hstep, voffA);
            PG8_WAIT_L(8); PG8_BAR; PG8_WAIT_L(0); PG8_MMA(0, 0, At, B0); PG8_BAR; PG8_SCHED;
            PG8_LDB(B1, 1, 1); PG8_STAGE(PG8_SB(1, 0), b3, voffB);
            PG8_BAR; PG8_WAIT_L(0); PG8_MMA(0, 1, At, B1); PG8_BAR;
            PG8_LDA(At, 1, 1); PG8_STAGE(PG8_SA(1, 0), a3, voffA);
            PG8_BAR; PG8_WAIT_L(0); PG8_MMA(1, 0, At, B0); PG8_BAR; PG8_SCHED;
            PG8_STAGE(PG8_SB(1, 1), b3 + hstep, voffB);
            PG8_WAIT_V(6); PG8_BAR; PG8_MMA(1, 1, At, B1); PG8_BAR;
            }
        }
        if constexpr (ALIGN_EPI) { if (wr == 0) PG8_BAR; }
        if constexpr (!Epi::AFTER_DRAIN) { E(acc, cur, wr, wc, fr, fq); S.done(cur); }
        if (!has_next) break;
#pragma unroll
        for (int a = 0; a < 2; ++a)
#pragma unroll
            for (int b = 0; b < 2; ++b)
#pragma unroll
                for (int m = 0; m < 4; ++m)
#pragma unroll
                    for (int n = 0; n < 2; ++n) acc[a][b][m][n] = (f32x4){0.f, 0.f, 0.f, 0.f};
        cur = nxt; cA = nA; cB = nB; ++ui;
        if constexpr (ALIGN_EPI) { if (wr == 1) PG8_BAR; }
    }
    PG8_WAIT_V(0);
    if constexpr (!ALIGN_EPI) { if (wr == 0) PG8_BAR; }
    PG8_BAR;
    if constexpr (Epi::AFTER_DRAIN) { E.fused(acc, cur, wr, wc, fr, fq, lds, wid, lane); S.done(cur); }
#undef PG8_SA
#undef PG8_SB
#undef PG8_STAGE
#undef PG8_LDA
#undef PG8_LDB
#undef PG8_MMA
#undef PG8_WAIT_V
#undef PG8_WAIT_L
#undef PG8_BAR
#undef PG8_SCHED
}
}

#ifndef PHM
#define PHM 1023
#endif
#ifndef REP_SP
#define REP_SP -1
#endif
#define LAS __attribute__((address_space(3)))
typedef unsigned short bf16;
typedef float f32x4 __attribute__((ext_vector_type(4)));
typedef float f32x16 __attribute__((ext_vector_type(16)));
typedef short bf16x8 __attribute__((ext_vector_type(8)));
typedef unsigned u32x4 __attribute__((ext_vector_type(4)));
typedef unsigned u32x2 __attribute__((ext_vector_type(2)));

constexpr int T_TOK = 16384, DM = 1024, SEQ = 2048, NLAYER = 4, DFF = 4096, NPROJ = 7936, DIN = 7696;
constexpr float ALPHA_DN = 1.6817928305074290f;
constexpr float LN_EPS = 1e-5f, RMS_EPS = 1e-6f;
constexpr int NTHREADS = 512;
constexpr int LDS_BYTES = 135424, LDS_MISC = 135168;

constexpr size_t MiB = (size_t)1 << 20;
constexpr size_t WS_MOD = 0, WS_BA = 1 * MiB, WS_HALO = 2 * MiB, WS_LAST = 7 * MiB, WS_BAR = 7 * MiB + 512 * 1024, WS_BAR_BYTES = 16384, WS_W = 8 * MiB;
constexpr size_t WS_WIN = WS_W, WS_WOA = WS_W + 16 * MiB, WS_WOB = WS_W + 18 * MiB, WS_WOUT = WS_W + 20 * MiB, WS_WFF1 = WS_W + 22 * MiB, WS_WFF2 = WS_W + 30 * MiB;
constexpr size_t WS_A = 46 * MiB, WS_GO = 78 * MiB, WS_WG = 110 * MiB, WS_INTRA = 142 * MiB, WS_OR = 158 * MiB, WS_PROJ = 190 * MiB;
constexpr size_t WS_Q = WS_PROJ, WS_K = WS_PROJ + 32 * MiB, WS_VT = WS_PROJ + 40 * MiB, WS_DQ = WS_PROJ + 48 * MiB, WS_DK = WS_PROJ + 80 * MiB, WS_DV = WS_PROJ + 112 * MiB;
constexpr size_t WS_Z = WS_PROJ + 144 * MiB, WS_GA = WS_PROJ + 176 * MiB, WS_GB = WS_PROJ + 208 * MiB, WS_END = WS_PROJ + 240 * MiB;
constexpr size_t WS_MP = WS_PROJ, WS_H = WS_PROJ, WS_Y = WS_PROJ + 128 * MiB;

__device__ __forceinline__ float bf2f(unsigned h) { return __uint_as_float(h << 16); }
typedef float f32x2_t __attribute__((ext_vector_type(2))); typedef __bf16 bf16x2_t __attribute__((ext_vector_type(2)));
__device__ __forceinline__ unsigned pk2(float lo, float hi) { f32x2_t v = {lo, hi}; bf16x2_t b = __builtin_convertvector(v, bf16x2_t); return __builtin_bit_cast(unsigned, b); }
__device__ __forceinline__ float sigm(float x) { return 1.f / (1.f + __expf(-x)); }
__device__ __forceinline__ float siluf(float x) { return x / (1.f + __expf(-x)); }
#define LDS_WAIT() asm volatile("s_waitcnt lgkmcnt(0)" ::: "memory")
__device__ __forceinline__ float shx(float v, int m, int lane) { return __int_as_float(__builtin_amdgcn_ds_bpermute((lane ^ m) << 2, __float_as_int(v))); }
__device__ __forceinline__ float shup(float v, int o, int lane) { return __int_as_float(__builtin_amdgcn_ds_bpermute((lane - o) << 2, __float_as_int(v))); }

#define XB_TMO      128
#define XB_XCNT(j)  (256  + 64 * (j))
#define XB_XSUB(j)  (1280 + 64 * (j))
#define XB_XGEN(j)  (2304 + 64 * (j))
#define XB_TOP      3328
#define XB_TOPGEN   3392
#define XCD_BAR_WORDS 3456
#define XB_SPIN_CAP (1u << 18)

__device__ __forceinline__ unsigned xb_ld(unsigned* p)              { return __hip_atomic_load(p, __ATOMIC_RELAXED, __HIP_MEMORY_SCOPE_AGENT); }
__device__ __forceinline__ unsigned xb_add(unsigned* p, unsigned v) { return __hip_atomic_fetch_add(p, v, __ATOMIC_RELAXED, __HIP_MEMORY_SCOPE_AGENT); }
__device__ __forceinline__ unsigned xb_xcc_id() { return (unsigned)__builtin_amdgcn_s_getreg((3 << 11) | 20) & 0xFu; }
#define XB_SPIN(cond, bar) do { unsigned _sp = 0; while (cond) { __builtin_amdgcn_s_sleep(1); \
    if ((++_sp & 255u) == 0u) { if (xb_ld(&(bar)[XB_TMO])) break; if (_sp > XB_SPIN_CAP) { atomicAdd(&(bar)[XB_TMO], 1u); break; } } } } while (0)

struct XcdBarrier {
    unsigned* bar; unsigned x;
    volatile LAS unsigned* st;
};

__device__ __forceinline__ XcdBarrier xcd_barrier_post(unsigned* bar, volatile LAS unsigned* st) {
    XcdBarrier b; b.bar = bar; b.x = xb_xcc_id(); b.st = st;
    if (threadIdx.x == 0) (void)xb_add(&bar[XB_XCNT(b.x)], 1u);
    return b;
}
__device__ __forceinline__ void xcd_barrier_complete(unsigned* bar, unsigned x, unsigned& nloc, unsigned& nx) {
    const unsigned G = gridDim.x * gridDim.y * gridDim.z;
    unsigned sum, cnt, mine, sp = 0u;
    for (;;) {
        sum = 0u; cnt = 0u; mine = 0u;
#pragma unroll
        for (unsigned j = 0; j < 16; ++j) { const unsigned c = xb_ld(&bar[XB_XCNT(j)]); sum += c; cnt += (c > 0u) ? 1u : 0u; mine = (j == x) ? c : mine; }
        if (sum == G) break;
        __builtin_amdgcn_s_sleep(1);
        if ((++sp & 255u) == 0u) { if (xb_ld(&bar[XB_TMO])) break; if (sp > XB_SPIN_CAP) { atomicAdd(&bar[XB_TMO], 1u); break; } }
    }
    nloc = mine > 0u ? mine : 1u; nx = cnt > 0u ? cnt : 1u;
}

__device__ __forceinline__ void xcd_barrier(const XcdBarrier& b) {
    asm volatile("s_waitcnt vmcnt(0)" ::: "memory");
    __syncthreads();
    if (threadIdx.x == 0) {
        unsigned* bar = b.bar;
        __builtin_amdgcn_s_waitcnt(0);
        unsigned nloc = b.st[0], nx = b.st[1];
        if (nloc == 0u) { xcd_barrier_complete(bar, b.x, nloc, nx); b.st[0] = nloc; b.st[1] = nx; }
        const unsigned old = xb_add(&bar[XB_XSUB(b.x)], 1u);
        const unsigned gen = old / nloc;
        if (old + 1u == (gen + 1u) * nloc) {
            __builtin_amdgcn_fence(__ATOMIC_RELEASE, "agent");
            asm volatile("s_waitcnt vmcnt(0)" ::: "memory");
            const unsigned og = xb_add(&bar[XB_TOP], 1u);
            const unsigned tg = og / nx;
            if (og + 1u == (tg + 1u) * nx) xb_add(&bar[XB_TOPGEN], 1u);
            else XB_SPIN(xb_ld(&bar[XB_TOPGEN]) == tg, bar);
            __builtin_amdgcn_fence(__ATOMIC_ACQUIRE, "agent");
            xb_add(&bar[XB_XGEN(b.x)], 1u);
            asm volatile("s_waitcnt vmcnt(0)" ::: "memory");
        } else {
            XB_SPIN(xb_ld(&bar[XB_XGEN(b.x)]) == gen, bar);
            __builtin_amdgcn_fence(__ATOMIC_ACQUIRE, "agent");
            asm volatile("s_waitcnt vmcnt(0)" ::: "memory");
        }
    }
    __syncthreads();
}

struct EpiProj {
    static constexpr bool PERM = true, AFTER_DRAIN = false;
    unsigned char* ws;
    __device__ __forceinline__ void operator()(const f32x4 (&acc)[2][2][4][2], const pg8::Unit& u, int wr, int wc, int fr, int fq) const {
        const int pn = u.pn; const int row0 = u.pm * 256 + wr * 64 + fr; const int cl0 = wc * 32 + 8 * fq;
#pragma unroll
        for (int ai = 0; ai < 2; ++ai)
#pragma unroll
            for (int m = 0; m < 4; ++m) {
                const int row = row0 + ai * 128 + m * 16;
#pragma unroll
                for (int bj = 0; bj < 2; ++bj) {
                    const int cl = cl0 + bj * 128; const f32x4 v0 = acc[ai][bj][m][0], v1 = acc[ai][bj][m][1];
                    u32x4 w; w.x = pk2(v0[0], v0[1]); w.y = pk2(v0[2], v0[3]); w.z = pk2(v1[0], v1[1]); w.w = pk2(v1[2], v1[3]);
                    if (pn < 4) { *(u32x4*)((bf16*)(ws + WS_Q) + (size_t)row * 1024 + pn * 256 + cl) = w; }
                    else if (pn == 4) { *(u32x4*)((bf16*)(ws + WS_K) + (size_t)row * 256 + cl) = w; }
                    else if (pn == 5) {
                        const int kvh = cl >> 6, d = cl & 63, b = row >> 11, s = row & 2047;
                        bf16* p = (bf16*)(ws + WS_VT) + ((size_t)((b * 4 + kvh) * 64 + d)) * 2048 + s;
                        p[0 * 2048] = (bf16)(w.x & 0xffff); p[1 * 2048] = (bf16)(w.x >> 16); p[2 * 2048] = (bf16)(w.y & 0xffff); p[3 * 2048] = (bf16)(w.y >> 16);
                        p[4 * 2048] = (bf16)(w.z & 0xffff); p[5 * 2048] = (bf16)(w.z >> 16); p[6 * 2048] = (bf16)(w.w & 0xffff); p[7 * 2048] = (bf16)(w.w >> 16);
                    }
                    else if (pn < 18) {
                        const int tsr = (pn - 6) >> 2, col = ((pn - 6) & 3) * 256 + cl, h = col >> 7, unit = (row >> 6) * 8 + h;
                        *(u32x4*)((bf16*)(ws + WS_DQ + (size_t)tsr * 32 * MiB) + (size_t)unit * 8192 + (row & 63) * 128 + (col & 127)) = w;
                        if ((row & 63) >= 61) *(u32x4*)((bf16*)(ws + WS_HALO) + ((size_t)(row >> 6) * 3 + ((row & 63) - 61)) * 3072 + tsr * 1024 + col) = w;
                    }
                    else if (pn < 30) {
                        const int tsr = (pn - 18) >> 2, col = ((pn - 18) & 3) * 256 + cl;
                        *(u32x4*)((bf16*)(ws + WS_Z + (size_t)tsr * 32 * MiB) + (size_t)row * 1024 + col) = w;
                    }
                    else if (cl < 16) { float* p = (float*)(ws + WS_BA) + (size_t)row * 16 + cl; *(f32x4*)p = v0; *(f32x4*)(p + 4) = v1; }
                }
            }
    }
};
template <bool FIRST> struct EpiGate {
    static constexpr bool PERM = true, AFTER_DRAIN = false;
    const bf16* G; bf16* MP;
    __device__ __forceinline__ void operator()(const f32x4 (&acc)[2][2][4][2], const pg8::Unit& u, int wr, int wc, int fr, int fq) const {
        const int row0 = u.pm * 256 + wr * 64 + fr; const int col0 = u.pn * 256 + wc * 32 + 8 * fq;
#pragma unroll
        for (int ai = 0; ai < 2; ++ai)
#pragma unroll
            for (int m = 0; m < 4; ++m) {
                const int row = row0 + ai * 128 + m * 16;
#pragma unroll
                for (int bj = 0; bj < 2; ++bj) {
                    const size_t idx = (size_t)row * 1024 + col0 + bj * 128; const f32x4 v0 = acc[ai][bj][m][0], v1 = acc[ai][bj][m][1];
                    const u32x4 g = *(const u32x4*)(G + idx);
                    float r[8];
                    r[0] = sigm(bf2f(g.x & 0xffff)) * v0[0]; r[1] = sigm(bf2f(g.x >> 16)) * v0[1]; r[2] = sigm(bf2f(g.y & 0xffff)) * v0[2]; r[3] = sigm(bf2f(g.y >> 16)) * v0[3];
                    r[4] = sigm(bf2f(g.z & 0xffff)) * v1[0]; r[5] = sigm(bf2f(g.z >> 16)) * v1[1]; r[6] = sigm(bf2f(g.w & 0xffff)) * v1[2]; r[7] = sigm(bf2f(g.w >> 16)) * v1[3];
                    if (!FIRST) { const u32x4 p = *(const u32x4*)(MP + idx);
                        r[0] += bf2f(p.x & 0xffff); r[1] += bf2f(p.x >> 16); r[2] += bf2f(p.y & 0xffff); r[3] += bf2f(p.y >> 16);
                        r[4] += bf2f(p.z & 0xffff); r[5] += bf2f(p.z >> 16); r[6] += bf2f(p.w & 0xffff); r[7] += bf2f(p.w >> 16); }
                    u32x4 w; w.x = pk2(r[0], r[1]); w.y = pk2(r[2], r[3]); w.z = pk2(r[4], r[5]); w.w = pk2(r[6], r[7]);
                    *(u32x4*)(MP + idx) = w;
                }
            }
    }
};
struct EpiResid {
    static constexpr bool PERM = true, AFTER_DRAIN = false;
    const float* X; float* Y; const float* gt; const float* bias;
    __device__ __forceinline__ void operator()(const f32x4 (&acc)[2][2][4][2], const pg8::Unit& u, int wr, int wc, int fr, int fq) const {
        const int row0 = u.pm * 256 + wr * 64 + fr; const int col0 = u.pn * 256 + wc * 32 + 8 * fq; const int b = u.pm >> 3;
#pragma unroll
        for (int bj = 0; bj < 2; ++bj) {
            const int col = col0 + bj * 128;
            f32x4 g0 = *(const f32x4*)(gt + b * 6144 + col) + 1.0f, g1 = *(const f32x4*)(gt + b * 6144 + col + 4) + 1.0f;
            f32x4 b0 = (f32x4){0.f, 0.f, 0.f, 0.f}, b1 = b0; if (bias) { b0 = *(const f32x4*)(bias + col); b1 = *(const f32x4*)(bias + col + 4); }
#pragma unroll
            for (int ai = 0; ai < 2; ++ai)
#pragma unroll
                for (int m = 0; m < 4; ++m) {
                    const size_t idx = (size_t)(row0 + ai * 128 + m * 16) * 1024 + col;
                    const f32x4 x0 = *(const f32x4*)(X + idx), x1 = *(const f32x4*)(X + idx + 4);
                    *(f32x4*)(Y + idx) = x0 * ALPHA_DN + g0 * (acc[ai][bj][m][0] + b0);
                    *(f32x4*)(Y + idx + 4) = x1 * ALPHA_DN + g1 * (acc[ai][bj][m][1] + b1);
                }
        }
    }
};
struct EpiFF1 {
    static constexpr bool PERM = true, AFTER_DRAIN = false;
    bf16* H; const float* bias;
    __device__ __forceinline__ void operator()(const f32x4 (&acc)[2][2][4][2], const pg8::Unit& u, int wr, int wc, int fr, int fq) const {
        const int row0 = u.pm * 256 + wr * 64 + fr; const int col0 = u.pn * 256 + wc * 32 + 8 * fq;
#pragma unroll
        for (int bj = 0; bj < 2; ++bj) {
            const int col = col0 + bj * 128;
            const f32x4 b0 = *(const f32x4*)(bias + col), b1 = *(const f32x4*)(bias + col + 4);
#pragma unroll
            for (int ai = 0; ai < 2; ++ai)
#pragma unroll
                for (int m = 0; m < 4; ++m) {
                    f32x4 v0 = acc[ai][bj][m][0] + b0, v1 = acc[ai][bj][m][1] + b1;
#pragma unroll
                    for (int e = 0; e < 4; ++e) { v0[e] = fmaxf(v0[e], 0.f); v0[e] *= v0[e]; v1[e] = fmaxf(v1[e], 0.f); v1[e] *= v1[e]; }
                    u32x4 w; w.x = pk2(v0[0], v0[1]); w.y = pk2(v0[2], v0[3]); w.z = pk2(v1[0], v1[1]); w.w = pk2(v1[2], v1[3]);
                    *(u32x4*)(H + (size_t)(row0 + ai * 128 + m * 16) * 4096 + col) = w;
                }
        }
    }
};

struct Ctx {
    const float* in[21]; float* out; unsigned char* ws;
    LAS unsigned char* lds; int tid, lane, wave, G, bid;
};
enum { I_X = 0, I_C, I_WADA, I_BADA, I_WIN, I_CONVW, I_ALOG, I_DTB, I_SINKS, I_DNW, I_WOA, I_WOB, I_WOUT, I_LN1G, I_LN1B, I_WFF1, I_BFF1, I_WFF2, I_BFF2, I_LN2G, I_LN2B };

__device__ __forceinline__ void phase_mod(const Ctx& C) {
    LAS float* cact = (LAS float*)C.lds;
    LAS float* red = (LAS float*)(C.lds + 32768);
    for (int i = C.tid; i < 8192; i += NTHREADS) cact[i] = siluf(C.in[I_C][i]);
    __syncthreads();
    float* mod = (float*)(C.ws + WS_MOD);
    for (int unit = C.bid; unit < 384; unit += C.G) {
        const int l = unit / 96, n0 = (unit % 96) * 64;
        const float* W = C.in[I_WADA] + (size_t)l * 1024 * 6144 + n0 + C.lane;
        float a[8];
#pragma unroll
        for (int b = 0; b < 8; ++b) a[b] = 0.f;
        const int k0 = C.wave * 128;
#pragma unroll 4
        for (int k = k0; k < k0 + 128; ++k) { const float w = W[(size_t)k * 6144];
#pragma unroll
            for (int b = 0; b < 8; ++b) a[b] += cact[b * 1024 + k] * w; }
#pragma unroll
        for (int b = 0; b < 8; ++b) red[(C.wave * 8 + b) * 64 + C.lane] = a[b];
        __syncthreads();
        { const int b = C.tid >> 6, ln = C.tid & 63; float s = 0.f;
#pragma unroll
          for (int w = 0; w < 8; ++w) s += red[(w * 8 + b) * 64 + ln];
          mod[(size_t)(l * 8 + b) * 6144 + n0 + ln] = s + C.in[I_BADA][l * 6144 + n0 + ln]; }
        __syncthreads();
    }
}

__device__ __forceinline__ int win_src_col(int n) { return n < 5632 ? n : (n < 7680 ? n + 16 : (n < 7696 ? n - 7680 + 5632 : -1)); }
__device__ __forceinline__ void tr_item(const float* W, int K, int N, bf16* WT, LAS float* scr, int item, int nblk, int lane, bool winmap) {
    const int kb = item / nblk, nb = item % nblk, k0 = 64 * kb, n0 = 32 * nb;
    const int n = n0 + (lane & 31); const int sc = winmap ? win_src_col(n) : n;
#pragma unroll 8
    for (int i = 0; i < 32; ++i) { const int kk = 2 * i + (lane >> 5); scr[kk * 33 + (lane & 31)] = (sc >= 0) ? W[(size_t)(k0 + kk) * N + sc] : 0.f; }
    LDS_WAIT();
    const int c = lane & 7;
#pragma unroll
    for (int j = 0; j < 4; ++j) { const int nn = (lane >> 3) + 8 * j; const LAS float* s = scr + (8 * c) * 33 + nn;
        u32x4 o; o.x = pk2(s[0 * 33], s[1 * 33]); o.y = pk2(s[2 * 33], s[3 * 33]); o.z = pk2(s[4 * 33], s[5 * 33]); o.w = pk2(s[6 * 33], s[7 * 33]);
        *(u32x4*)(WT + (size_t)(n0 + nn) * K + k0 + 8 * c) = o; }
    LDS_WAIT();
}
__device__ __forceinline__ void phase_convert(const Ctx& C, int l) {
    LAS float* scr = (LAS float*)(C.lds + 65536 + C.wave * 8704);
    const int gw = C.bid * 8 + C.wave, NGW = C.G * 8;
    constexpr int I_IN = 16 * 248, I_O = 16 * 32, I_1 = 16 * 128, I_2 = 64 * 32;
    constexpr int NIT = I_IN + 3 * I_O + I_1 + I_2;
    for (int it = gw; it < NIT; it += NGW) {
        int r = it;
        if (r < I_IN) { tr_item(C.in[I_WIN] + (size_t)l * 1024 * DIN, 1024, DIN, (bf16*)(C.ws + WS_WIN), scr, r, 248, C.lane, true); continue; } r -= I_IN;
        if (r < I_O) { tr_item(C.in[I_WOA] + (size_t)l * 1024 * 1024, 1024, 1024, (bf16*)(C.ws + WS_WOA), scr, r, 32, C.lane, false); continue; } r -= I_O;
        if (r < I_O) { tr_item(C.in[I_WOB] + (size_t)l * 1024 * 1024, 1024, 1024, (bf16*)(C.ws + WS_WOB), scr, r, 32, C.lane, false); continue; } r -= I_O;
        if (r < I_O) { tr_item(C.in[I_WOUT] + (size_t)l * 1024 * 1024, 1024, 1024, (bf16*)(C.ws + WS_WOUT), scr, r, 32, C.lane, false); continue; } r -= I_O;
        if (r < I_1) { tr_item(C.in[I_WFF1] + (size_t)l * 1024 * 4096, 1024, 4096, (bf16*)(C.ws + WS_WFF1), scr, r, 128, C.lane, false); continue; } r -= I_1;
        tr_item(C.in[I_WFF2] + (size_t)l * 4096 * 1024, 4096, 1024, (bf16*)(C.ws + WS_WFF2), scr, r, 32, C.lane, false);
    }
}

__device__ __forceinline__ float wave_sum(float v, int lane) {
#pragma unroll
    for (int o = 1; o < 64; o <<= 1) v += shx(v, o, lane);
    return v;
}
__device__ __forceinline__ void phase_modulate(const Ctx& C, const float* X, const float* modl  , int shoff, int scoff, bf16* U) {
    const int gw = C.bid * 8 + C.wave, NGW = C.G * 8;
    for (int row = gw; row < T_TOK; row += NGW) {
        const int b = row >> 11; const float* mb = modl + b * 6144;
#pragma unroll
        for (int j = 0; j < 4; ++j) { const int col = 4 * C.lane + 256 * j;
            const f32x4 x = *(const f32x4*)(X + (size_t)row * 1024 + col), sc = *(const f32x4*)(mb + scoff + col), sh = *(const f32x4*)(mb + shoff + col);
            const f32x4 u = x * (sc + 1.0f) + sh; u32x2 w; w.x = pk2(u[0], u[1]); w.y = pk2(u[2], u[3]);
            *(u32x2*)(U + (size_t)row * 1024 + col) = w; }
    }
}
__device__ __forceinline__ void phase_ln(const Ctx& C, const float* Y, float* X, const float* g, const float* bta, const float* modn, int shoff, int scoff, bf16* U) {
    const int gw = C.bid * 8 + C.wave, NGW = C.G * 8;
    for (int row0 = gw; row0 < T_TOK; row0 += 2 * NGW) {
        f32x4 v[2][4]; float s[2], s2[2], mean[2], rstd[2];
#pragma unroll
        for (int r = 0; r < 2; ++r) { const int row = row0 + r * NGW; s[r] = 0.f;
#pragma unroll
            for (int j = 0; j < 4; ++j) { v[r][j] = *(const f32x4*)(Y + (size_t)row * 1024 + 4 * C.lane + 256 * j); s[r] += (v[r][j][0] + v[r][j][1]) + (v[r][j][2] + v[r][j][3]); } }
#pragma unroll
        for (int r = 0; r < 2; ++r) { mean[r] = wave_sum(s[r], C.lane) * (1.f / 1024.f); s2[r] = 0.f;
#pragma unroll
            for (int j = 0; j < 4; ++j) { v[r][j] = v[r][j] - mean[r]; s2[r] += (v[r][j][0] * v[r][j][0] + v[r][j][1] * v[r][j][1]) + (v[r][j][2] * v[r][j][2] + v[r][j][3] * v[r][j][3]); } }
#pragma unroll
        for (int r = 0; r < 2; ++r) rstd[r] = 1.f / sqrtf(wave_sum(s2[r], C.lane) * (1.f / 1024.f) + LN_EPS);
#pragma unroll
        for (int r = 0; r < 2; ++r) { const int row = row0 + r * NGW; const int b = row >> 11;
#pragma unroll
            for (int j = 0; j < 4; ++j) { const int col = 4 * C.lane + 256 * j;
                const f32x4 x = v[r][j] * rstd[r] * *(const f32x4*)(g + col) + *(const f32x4*)(bta + col);
                *(f32x4*)(X + (size_t)row * 1024 + col) = x;
                if (U) { const float* mb = modn + b * 6144; const f32x4 sc = *(const f32x4*)(mb + scoff + col), sh = *(const f32x4*)(mb + shoff + col);
                    const f32x4 u = x * (sc + 1.0f) + sh; u32x2 w; w.x = pk2(u[0], u[1]); w.y = pk2(u[2], u[3]);
                    *(u32x2*)(U + (size_t)row * 1024 + col) = w; }
            } }
    }
}

__device__ __forceinline__ void attn_unit(const bf16* Q, const bf16* K, const bf16* VT, bf16* AO, float sink, int b, int h, int qt, int lane) {
    const int q = lane & 31, hi = lane >> 5, kvh = h >> 2, q0 = qt * 32;
    const bf16* qp = Q + (size_t)(b * 2048 + q0 + q) * 1024 + h * 64 + hi * 8;
    bf16x8 qf[4];
#pragma unroll
    for (int d0 = 0; d0 < 4; ++d0) qf[d0] = *(const bf16x8*)(qp + d0 * 16);
    const int pi = (q & 0x13) | ((q & 8) >> 1) | ((q & 4) << 1);
    const int jmin = (qt >= 4) ? 0 : (4 - qt);
    bf16x8 kf[5][4];
#pragma unroll
    for (int j = 0; j < 5; ++j) {
        const int kv0 = (j >= jmin) ? q0 - 128 + 32 * j : 0;
        const bf16* kp = K + (size_t)(b * 2048 + kv0 + pi) * 256 + kvh * 64 + hi * 8;
#pragma unroll
        for (int d0 = 0; d0 < 4; ++d0) kf[j][d0] = *(const bf16x8*)(kp + d0 * 16);
    }
    f32x16 s[5];
#pragma unroll
    for (int j = 0; j < 5; ++j) {
        f32x16 a;
#pragma unroll
        for (int r = 0; r < 16; ++r) a[r] = 0.f;
#pragma unroll
        for (int d0 = 0; d0 < 4; ++d0) a = __builtin_amdgcn_mfma_f32_32x32x16_bf16(kf[j][d0], qf[d0], a, 0, 0, 0);
        s[j] = a;
    }
    bf16x8 vf[5][2][2];
#pragma unroll
    for (int j = 0; j < 5; ++j) {
        const int kv0 = (j >= jmin) ? q0 - 128 + 32 * j : 0;
#pragma unroll
        for (int sl = 0; sl < 2; ++sl)
#pragma unroll
            for (int dh = 0; dh < 2; ++dh) vf[j][sl][dh] = *(const bf16x8*)(VT + ((size_t)((b * 4 + kvh) * 64 + 32 * dh + q)) * 2048 + kv0 + 16 * sl + 8 * hi);
    }
    float m = sink;
#pragma unroll
    for (int j = 0; j < 5; ++j)
#pragma unroll
        for (int r = 0; r < 16; ++r) {
            const int off = 16 * (r >> 3) + 8 * hi + (r & 7);
            bool valid = (j >= jmin);
            if (j == 0) valid = valid && (off > q);
            if (j == 4) valid = valid && (off <= q);
            const float v = valid ? s[j][r] * 0.125f : -INFINITY;
            s[j][r] = v; m = fmaxf(m, v);
        }
    m = fmaxf(m, shx(m, 32, lane));
    float sum = 0.f;
#pragma unroll
    for (int j = 0; j < 5; ++j)
#pragma unroll
        for (int r = 0; r < 16; ++r) { const float p = __expf(s[j][r] - m); s[j][r] = p; sum += p; }
    sum += shx(sum, 32, lane);
    const float inv = 1.f / (sum + __expf(sink - m));
    f32x16 o[2];
#pragma unroll
    for (int dh = 0; dh < 2; ++dh)
#pragma unroll
        for (int r = 0; r < 16; ++r) o[dh][r] = 0.f;
#pragma unroll
    for (int j = 0; j < 5; ++j) {
#pragma unroll
        for (int sl = 0; sl < 2; ++sl) {
            u32x4 pw; pw.x = pk2(s[j][8 * sl + 0] * inv, s[j][8 * sl + 1] * inv); pw.y = pk2(s[j][8 * sl + 2] * inv, s[j][8 * sl + 3] * inv);
            pw.z = pk2(s[j][8 * sl + 4] * inv, s[j][8 * sl + 5] * inv); pw.w = pk2(s[j][8 * sl + 6] * inv, s[j][8 * sl + 7] * inv);
            const bf16x8 pf = __builtin_bit_cast(bf16x8, pw);
#pragma unroll
            for (int dh = 0; dh < 2; ++dh) o[dh] = __builtin_amdgcn_mfma_f32_32x32x16_bf16(vf[j][sl][dh], pf, o[dh], 0, 0, 0);
        }
    }
    bf16* op = AO + (size_t)(b * 2048 + q0 + q) * 1024 + h * 64;
#pragma unroll
    for (int dh = 0; dh < 2; ++dh)
#pragma unroll
        for (int rr = 0; rr < 4; ++rr) { u32x2 w; w.x = pk2(o[dh][4 * rr + 0], o[dh][4 * rr + 1]); w.y = pk2(o[dh][4 * rr + 2], o[dh][4 * rr + 3]);
            *(u32x2*)(op + 32 * dh + 8 * rr + 4 * hi) = w; }
}
__device__ __forceinline__ void phase_attn_post(const Ctx& C, int l) {
    const int gw = C.bid * 8 + C.wave, NGW = C.G * 8;
    const bf16* Q = (const bf16*)(C.ws + WS_Q); const bf16* K = (const bf16*)(C.ws + WS_K); const bf16* VT = (const bf16*)(C.ws + WS_VT); bf16* AO = (bf16*)(C.ws + WS_A);
    for (int u = gw; u < 8192; u += NGW) {
        const int hg = u & 3, qt = (u >> 2) & 63, kvh = (u >> 8) & 3, b = u >> 10; const int h = kvh * 4 + hg;
        attn_unit(Q, K, VT, AO, C.in[I_SINKS][l * 16 + h], b, h, qt, C.lane);
    }
    const bf16* OR = (const bf16*)(C.ws + WS_OR); const bf16* Z = (const bf16*)(C.ws + WS_Z); bf16* GO = (bf16*)(C.ws + WS_GO);
    const float* nw = C.in[I_DNW] + l * 128 + (C.lane & 7) * 16;
    for (int row = gw; row < T_TOK; row += NGW) {
        const size_t idx = (size_t)row * 1024 + C.lane * 16;
        const u32x4 o0 = *(const u32x4*)(OR + idx), o1 = *(const u32x4*)(OR + idx + 8), z0 = *(const u32x4*)(Z + idx), z1 = *(const u32x4*)(Z + idx + 8);
        float ov[16], zv[16];
#pragma unroll
        for (int e = 0; e < 4; ++e) { ov[2 * e] = bf2f(o0[e] & 0xffff); ov[2 * e + 1] = bf2f(o0[e] >> 16); ov[8 + 2 * e] = bf2f(o1[e] & 0xffff); ov[8 + 2 * e + 1] = bf2f(o1[e] >> 16);
            zv[2 * e] = bf2f(z0[e] & 0xffff); zv[2 * e + 1] = bf2f(z0[e] >> 16); zv[8 + 2 * e] = bf2f(z1[e] & 0xffff); zv[8 + 2 * e + 1] = bf2f(z1[e] >> 16); }
        float ss = 0.f;
#pragma unroll
        for (int e = 0; e < 16; ++e) ss += ov[e] * ov[e];
        ss += shx(ss, 1, C.lane); ss += shx(ss, 2, C.lane); ss += shx(ss, 4, C.lane);
        const float rms = 1.f / sqrtf(ss * (1.f / 128.f) + RMS_EPS);
        unsigned w[8];
#pragma unroll
        for (int e = 0; e < 8; ++e) { const float a = ov[2 * e] * rms * nw[2 * e] * siluf(zv[2 * e]), c = ov[2 * e + 1] * rms * nw[2 * e + 1] * siluf(zv[2 * e + 1]); w[e] = pk2(a, c); }
        *(u32x4*)(GO + idx) = (u32x4){w[0], w[1], w[2], w[3]}; *(u32x4*)(GO + idx + 8) = (u32x4){w[4], w[5], w[6], w[7]};
    }
}

constexpr int PL_RAW = 0, PL_XS = 0, PL_IM = 33792, PL_QS = 51456, PL_KS = 68864, PL_VS = 86272, PL_LM = 103680, PL_SC = 121088, PL_CW = 122880;
constexpr int QS_LD = 136, XS_LD = 264, LM_LD = 68, IM_LD = 72;
__device__ __forceinline__ int sigma_idx(int kk, int quad, int jj) { return 16 * (2 * kk + (jj >> 2)) + 4 * quad + (jj & 3); }
__device__ __forceinline__ void gdn_prep_unit(const Ctx& C, int l, int unit) {
    int tid = C.tid; asm volatile("" : "+v"(tid));
    const int lane = tid & 63, wave = C.wave;
    const int h = unit & 7, gc = unit >> 3, c = gc & 31;
    LAS unsigned char* lb = C.lds; asm volatile("" : "+v"(lb));
    LAS bf16* RAW = (LAS bf16*)(lb + PL_RAW);
    LAS bf16* XS = (LAS bf16*)(lb + PL_XS);
    LAS bf16* IM = (LAS bf16*)(lb + PL_IM);
    LAS bf16* QS = (LAS bf16*)(lb + PL_QS); LAS bf16* KS = (LAS bf16*)(lb + PL_KS); LAS bf16* VS = (LAS bf16*)(lb + PL_VS);
    LAS float* LM = (LAS float*)(lb + PL_LM);
    LAS float* SC = (LAS float*)(lb + PL_SC);
    LAS float* CW = (LAS float*)(lb + PL_CW);
    bf16* DQ = (bf16*)(C.ws + WS_DQ) + (size_t)unit * 8192; bf16* DK = (bf16*)(C.ws + WS_DK) + (size_t)unit * 8192; bf16* DV = (bf16*)(C.ws + WS_DV) + (size_t)unit * 8192;
    bf16* WG = (bf16*)(C.ws + WS_WG) + (size_t)unit * 8192; bf16* IG = (bf16*)(C.ws + WS_INTRA) + (size_t)unit * 4096;
    if (wave == 0) {
        const float* ba = (const float*)(C.ws + WS_BA) + (size_t)(gc * 64 + lane) * 16;
        const float braw = ba[h], araw = ba[8 + h];
        const float beta = sigm(braw); const float xx = araw + C.in[I_DTB][l * 8 + h];
        const float ex = __expf(-fabsf(xx)); const float sp = fmaxf(xx, 0.f) + (ex < 1e-3f ? ex * (1.f - 0.5f * ex) : __logf(1.f + ex));
        float g = -__expf(C.in[I_ALOG][l * 8 + h]) * sp;
#pragma unroll
        for (int o = 1; o < 64; o <<= 1) { const float t = shup(g, o, lane); if (lane >= o) g += t; }
        const float glast = __int_as_float(__builtin_amdgcn_readlane(__float_as_int(g), 63));
        SC[lane] = g; SC[64 + lane] = beta; SC[128 + lane] = __expf(g); SC[192 + lane] = __expf(glast - g);
        if (lane == 63) ((float*)(C.ws + WS_LAST))[unit] = __expf(g);
    }
    {
        f32x4 cwv = (f32x4){0.f, 0.f, 0.f, 0.f};
        if (tid < 384) { const int j = tid / 96, rem = tid % 96, tsr = rem >> 5, c4 = rem & 31; cwv = *(const f32x4*)(C.in[I_CONVW] + (size_t)l * 4 * 3072 + j * 3072 + tsr * 1024 + h * 128 + c4 * 4); }
#pragma unroll 1
        for (int id = tid; id < 3 * 67 * 16; id += 2 * NTHREADS) {
            const int id2 = id + NTHREADS; u32x4 v0 = (u32x4){0u, 0u, 0u, 0u}, v1 = v0;
            { const int tsr = id / (67 * 16), rem = id % (67 * 16), r = rem >> 4, ch = rem & 15;
              if (r >= 3) v0 = *(const u32x4*)((const bf16*)(C.ws + WS_DQ + (size_t)tsr * 32 * MiB) + (size_t)unit * 8192 + (r - 3) * 128 + ch * 8);
              else if (c > 0) v0 = *(const u32x4*)((const bf16*)(C.ws + WS_HALO) + ((size_t)(gc - 1) * 3 + r) * 3072 + tsr * 1024 + h * 128 + ch * 8); }
            if (id2 < 3 * 67 * 16) { const int tsr = id2 / (67 * 16), rem = id2 % (67 * 16), r = rem >> 4, ch = rem & 15;
              if (r >= 3) v1 = *(const u32x4*)((const bf16*)(C.ws + WS_DQ + (size_t)tsr * 32 * MiB) + (size_t)unit * 8192 + (r - 3) * 128 + ch * 8);
              else if (c > 0) v1 = *(const u32x4*)((const bf16*)(C.ws + WS_HALO) + ((size_t)(gc - 1) * 3 + r) * 3072 + tsr * 1024 + h * 128 + ch * 8); }
            *(LAS u32x4*)(RAW + id * 8) = v0;
            if (id2 < 3 * 67 * 16) *(LAS u32x4*)(RAW + id2 * 8) = v1;
        }
        if (tid < 384) *(LAS f32x4*)(CW + tid * 4) = cwv;
    }
    __syncthreads();
    {
        const int row = tid >> 3, seg = tid & 7, ch0 = seg * 16;
        float val[3][16];
#pragma unroll
        for (int tsr = 0; tsr < 3; ++tsr) {
            const float* cw = C.in[I_CONVW] + (size_t)l * 4 * 3072 + tsr * 1024 + h * 128 + ch0;
#pragma unroll
            for (int e = 0; e < 16; ++e) val[tsr][e] = 0.f;
#pragma unroll
            for (int j = 0; j < 4; ++j) {
                const u32x4 r0 = *(const LAS u32x4*)(RAW + (tsr * 67 + row + j) * 128 + ch0), r1 = *(const LAS u32x4*)(RAW + (tsr * 67 + row + j) * 128 + ch0 + 8);
                const f32x4 w0 = *(const f32x4*)(cw + j * 3072), w1 = *(const f32x4*)(cw + j * 3072 + 4), w2 = *(const f32x4*)(cw + j * 3072 + 8), w3 = *(const f32x4*)(cw + j * 3072 + 12);
#pragma unroll
                for (int e = 0; e < 4; ++e) {
                    val[tsr][2 * e] += bf2f(r0[e] & 0xffff) * (e < 2 ? w0[2 * e] : w1[2 * e - 4]);
                    val[tsr][2 * e + 1] += bf2f(r0[e] >> 16) * (e < 2 ? w0[2 * e + 1] : w1[2 * e - 3]);
                    val[tsr][8 + 2 * e] += bf2f(r1[e] & 0xffff) * (e < 2 ? w2[2 * e] : w3[2 * e - 4]);
                    val[tsr][8 + 2 * e + 1] += bf2f(r1[e] >> 16) * (e < 2 ? w2[2 * e + 1] : w3[2 * e - 3]);
                }
            }
#pragma unroll
            for (int e = 0; e < 16; ++e) val[tsr][e] = siluf(val[tsr][e]);
        }
        float sq = 0.f, sk = 0.f;
#pragma unroll
        for (int e = 0; e < 16; ++e) { sq += val[0][e] * val[0][e]; sk += val[1][e] * val[1][e]; }
        sq += shx(sq, 1, lane); sq += shx(sq, 2, lane); sq += shx(sq, 4, lane);
        sk += shx(sk, 1, lane); sk += shx(sk, 2, lane); sk += shx(sk, 4, lane);
        const float rq = (1.f / sqrtf(sq + RMS_EPS)) * 0.08838834764831845f, rk = 1.f / sqrtf(sk + RMS_EPS);
        unsigned wq[8], wk[8], wv[8];
#pragma unroll
        for (int e = 0; e < 8; ++e) { wq[e] = pk2(val[0][2 * e] * rq, val[0][2 * e + 1] * rq); wk[e] = pk2(val[1][2 * e] * rk, val[1][2 * e + 1] * rk); wv[e] = pk2(val[2][2 * e], val[2][2 * e + 1]); }
        __syncthreads();
        *(LAS u32x4*)(QS + row * QS_LD + ch0) = (u32x4){wq[0], wq[1], wq[2], wq[3]}; *(LAS u32x4*)(QS + row * QS_LD + ch0 + 8) = (u32x4){wq[4], wq[5], wq[6], wq[7]};
        *(LAS u32x4*)(KS + row * QS_LD + ch0) = (u32x4){wk[0], wk[1], wk[2], wk[3]}; *(LAS u32x4*)(KS + row * QS_LD + ch0 + 8) = (u32x4){wk[4], wk[5], wk[6], wk[7]};
        *(LAS u32x4*)(VS + row * QS_LD + ch0) = (u32x4){wv[0], wv[1], wv[2], wv[3]}; *(LAS u32x4*)(VS + row * QS_LD + ch0 + 8) = (u32x4){wv[4], wv[5], wv[6], wv[7]};
    }
    __syncthreads();
    {
        const int mat = wave >> 2, mt = wave & 3, fr = lane & 15, quad = lane >> 4;
        LAS bf16* AS = mat ? QS : KS;
        bf16x8 af[4];
#pragma unroll
        for (int ks = 0; ks < 4; ++ks) af[ks] = *(const LAS bf16x8*)(AS + (16 * mt + fr) * QS_LD + 32 * ks + 8 * quad);
#pragma unroll
        for (int nt = 0; nt < 4; ++nt) {
            f32x4 a = (f32x4){0.f, 0.f, 0.f, 0.f};
#pragma unroll
            for (int ks = 0; ks < 4; ++ks) { const bf16x8 bfr = *(const LAS bf16x8*)(KS + (16 * nt + fr) * QS_LD + 32 * ks + 8 * quad); a = __builtin_amdgcn_mfma_f32_16x16x32_bf16(af[ks], bfr, a, 0, 0, 0); }
            const int j = 16 * nt + fr; const float gj = SC[j];
            f32x4 lt4;
#pragma unroll
            for (int e = 0; e < 4; ++e) {
                const int i = 16 * mt + 4 * quad + e; const float gi = SC[i];
                const float dec = __expf(fminf(gi - gj, 0.f));
                if (mat == 0) lt4[e] = (i > j) ? SC[64 + i] * a[e] * dec : 0.f;
                else IM[i * IM_LD + j] = (bf16)(pk2((i >= j) ? a[e] * dec : 0.f, 0.f) & 0xffff);
            }
            if (mat == 0) *(LAS f32x4*)(LM + j * LM_LD + 16 * mt + 4 * quad) = lt4;
        }
    }
    __syncthreads();
    if (tid < 256) {
        float x[64];
        const bool isv = tid < 128; const int cc = isv ? tid : tid - 128;
#pragma unroll
        for (int i = 0; i < 64; ++i) { const float bt = SC[64 + i]; x[i] = isv ? bf2f(VS[i * QS_LD + cc]) * bt : bf2f(KS[i * QS_LD + cc]) * bt * SC[128 + i]; }
        typedef float f32x2s __attribute__((ext_vector_type(2)));
#pragma unroll
        for (int ib = 0; ib < 16; ++ib) {
            f32x2s s01 = {x[4 * ib], x[4 * ib + 1]}, s23 = {x[4 * ib + 2], x[4 * ib + 3]};
#pragma unroll
            for (int j = 0; j < 4 * ib; ++j) {
                const f32x4 lt = *(const LAS f32x4*)(LM + j * LM_LD + 4 * ib);
                const f32x2s xj = {x[j], x[j]}, la = {lt[0], lt[1]}, lb = {lt[2], lt[3]};
                s01 -= la * xj; s23 -= lb * xj;
            }
            const f32x4 l0 = *(const LAS f32x4*)(LM + (4 * ib + 0) * LM_LD + 4 * ib), l1 = *(const LAS f32x4*)(LM + (4 * ib + 1) * LM_LD + 4 * ib), l2 = *(const LAS f32x4*)(LM + (4 * ib + 2) * LM_LD + 4 * ib);
            const float x0 = s01[0];
            const float x1 = s01[1] - l0[1] * x0;
            const float x2 = s23[0] - l0[2] * x0 - l1[2] * x1;
            const float x3 = s23[1] - l0[3] * x0 - l1[3] * x1 - l2[3] * x2;
            x[4 * ib] = x0; x[4 * ib + 1] = x1; x[4 * ib + 2] = x2; x[4 * ib + 3] = x3;
            asm volatile("" ::: "memory");
        }
#pragma unroll
        for (int i = 0; i < 64; ++i) XS[i * XS_LD + tid] = (bf16)(pk2(x[i], 0.f) & 0xffff);
    } else {
        const int t2 = tid - 256;
#pragma unroll
        for (int n = 0; n < 4; ++n) { const int id = t2 + 256 * n, mt = id >> 8, ks = (id >> 6) & 3, ln = id & 63; const int row = 16 * mt + (ln & 15), col = 32 * ks + 8 * (ln >> 4);
            const u32x4 v = *(const LAS u32x4*)(QS + row * QS_LD + col); const float sc = SC[128 + row]; u32x4 w;
#pragma unroll
            for (int e = 0; e < 4; ++e) w[e] = pk2(bf2f(v[e] & 0xffff) * sc, bf2f(v[e] >> 16) * sc);
            *(u32x4*)(DQ + (size_t)id * 8) = w; }
#pragma unroll
        for (int n = 0; n < 4; ++n) { const int id = t2 + 256 * n, mtk = id >> 7, kk = (id >> 6) & 1, ln = id & 63; const int kcol = 16 * mtk + (ln & 15), quad = ln >> 4; float f[8];
#pragma unroll
            for (int jj = 0; jj < 8; ++jj) { const int i = sigma_idx(kk, quad, jj); f[jj] = bf2f(KS[i * QS_LD + kcol]) * SC[192 + i]; }
            *(u32x4*)(DK + (size_t)id * 8) = (u32x4){pk2(f[0], f[1]), pk2(f[2], f[3]), pk2(f[4], f[5]), pk2(f[6], f[7])}; }
#pragma unroll
        for (int n = 0; n < 2; ++n) { const int id = t2 + 256 * n, mt = id >> 7, kk = (id >> 6) & 1, ln = id & 63; const int row = 16 * mt + (ln & 15), quad = ln >> 4;
            const u32x2 a = *(const LAS u32x2*)(IM + row * IM_LD + 32 * kk + 4 * quad), b2 = *(const LAS u32x2*)(IM + row * IM_LD + 32 * kk + 16 + 4 * quad);
            *(u32x4*)(IG + (size_t)id * 8) = (u32x4){a.x, a.y, b2.x, b2.y}; }
    }
    __syncthreads();
#pragma unroll
    for (int n = 0; n < 2; ++n) { const int id = tid + 512 * n, mt = id >> 8, ks = (id >> 6) & 3, ln = id & 63; const int row = 16 * mt + (ln & 15), col = 128 + 32 * ks + 8 * (ln >> 4);
        *(u32x4*)(WG + (size_t)id * 8) = *(const LAS u32x4*)(XS + row * XS_LD + col); }
#pragma unroll
    for (int n = 0; n < 4; ++n) { const int id = tid + 512 * n, vs = id >> 9, mt = (id >> 7) & 3, nt = (id >> 6) & 1, ln = id & 63; const int r0 = 16 * mt + 4 * (ln >> 4), col = 32 * vs + 16 * nt + (ln & 15);
        const unsigned a0 = XS[(r0 + 0) * XS_LD + col], a1 = XS[(r0 + 1) * XS_LD + col], a2 = XS[(r0 + 2) * XS_LD + col], a3 = XS[(r0 + 3) * XS_LD + col];
        *(u32x2*)(DV + (size_t)id * 4) = (u32x2){a0 | (a1 << 16), a2 | (a3 << 16)}; }
    __syncthreads();
}

constexpr int SL_ST = 0, SL_VF = 16384, ST_LD = 136;
__device__ __forceinline__ void gdn_scan_unit(const Ctx& C, int su) {
    const int lane = C.lane, wave = C.wave, fr = lane & 15, quad = lane >> 4;
    const int bh = su >> 2, vs = su & 3, b = bh >> 3, h = bh & 7;
    LAS bf16* ST = (LAS bf16*)(C.lds + SL_ST);
    LAS u32x4* VF = (LAS u32x4*)(C.lds + SL_VF);
    for (int i = C.tid; i < 32 * ST_LD / 2; i += NTHREADS) ((LAS unsigned*)ST)[i] = 0u;
    f32x4 sacc[2]; sacc[0] = (f32x4){0.f, 0.f, 0.f, 0.f}; sacc[1] = sacc[0];
    const bool isw = wave < 4; const int x = wave & 3, xp = x >> 1, nt = x & 1;
    bf16* OR = (bf16*)(C.ws + WS_OR);
    __syncthreads();
    bf16x8 af[2][4], kf[2], ifr[2][2]; u32x2 uf[2]; float last;
    bf16x8 naf[2][4], nkf[2], nifr[2][2]; u32x2 nuf[2]; float nlast;
#define SCAN_LOAD(AFv, KFv, IFv, UFv, LASTv, cc) do { \
        const size_t unit_ = (size_t)((b * 32 + (cc)) * 8 + h); \
        const bf16* AF_ = (const bf16*)(C.ws + (isw ? WS_WG : WS_DQ)) + unit_ * 8192; \
        const bf16* KF_ = (const bf16*)(C.ws + WS_DK) + unit_ * 8192; const bf16* UF_ = (const bf16*)(C.ws + WS_DV) + unit_ * 8192; const bf16* IG_ = (const bf16*)(C.ws + WS_INTRA) + unit_ * 4096; \
        LASTv = ((const float*)(C.ws + WS_LAST))[unit_]; \
        _Pragma("unroll") for (int mi = 0; mi < 2; ++mi) _Pragma("unroll") for (int ks = 0; ks < 4; ++ks) AFv[mi][ks] = *(const bf16x8*)(AF_ + (size_t)(((2 * xp + mi) * 4 + ks) * 64 + lane) * 8); \
        _Pragma("unroll") for (int kk = 0; kk < 2; ++kk) KFv[kk] = *(const bf16x8*)(KF_ + (size_t)((wave * 2 + kk) * 64 + lane) * 8); \
        if (isw) { _Pragma("unroll") for (int mi = 0; mi < 2; ++mi) UFv[mi] = *(const u32x2*)(UF_ + (size_t)(((vs * 4 + 2 * xp + mi) * 2 + nt) * 64 + lane) * 4); } \
        else { _Pragma("unroll") for (int mi = 0; mi < 2; ++mi) _Pragma("unroll") for (int kk = 0; kk < 2; ++kk) IFv[mi][kk] = *(const bf16x8*)(IG_ + (size_t)(((2 * xp + mi) * 2 + kk) * 64 + lane) * 8); } \
    } while (0)
    SCAN_LOAD(naf, nkf, nifr, nuf, nlast, 0);
    for (int c = 0; c < 32; ++c) {
#pragma unroll
        for (int mi = 0; mi < 2; ++mi) {
#pragma unroll
            for (int ks = 0; ks < 4; ++ks) af[mi][ks] = naf[mi][ks];
#pragma unroll
            for (int kk = 0; kk < 2; ++kk) ifr[mi][kk] = nifr[mi][kk];
            uf[mi] = nuf[mi]; }
        kf[0] = nkf[0]; kf[1] = nkf[1]; last = nlast;
        if (c + 1 < 32) SCAN_LOAD(naf, nkf, nifr, nuf, nlast, c + 1);
        bf16x8 sb[4];
#pragma unroll
        for (int ks = 0; ks < 4; ++ks) sb[ks] = *(const LAS bf16x8*)(ST + (16 * nt + fr) * ST_LD + 32 * ks + 8 * quad);
        f32x4 acc[2];
#pragma unroll
        for (int mi = 0; mi < 2; ++mi) { acc[mi] = (f32x4){0.f, 0.f, 0.f, 0.f};
#pragma unroll
            for (int ks = 0; ks < 4; ++ks) acc[mi] = __builtin_amdgcn_mfma_f32_16x16x32_bf16(af[mi][ks], sb[ks], acc[mi], 0, 0, 0); }
        if (isw) {
            float vn[8];
#pragma unroll
            for (int mi = 0; mi < 2; ++mi) { vn[4 * mi + 0] = bf2f(uf[mi].x & 0xffff) - acc[mi][0]; vn[4 * mi + 1] = bf2f(uf[mi].x >> 16) - acc[mi][1]; vn[4 * mi + 2] = bf2f(uf[mi].y & 0xffff) - acc[mi][2]; vn[4 * mi + 3] = bf2f(uf[mi].y >> 16) - acc[mi][3]; }
            VF[(xp * 2 + nt) * 64 + lane] = (u32x4){pk2(vn[0], vn[1]), pk2(vn[2], vn[3]), pk2(vn[4], vn[5]), pk2(vn[6], vn[7])};
        }
        LDS_WAIT(); __builtin_amdgcn_s_barrier(); asm volatile("" ::: "memory");
        bf16x8 vb[2][2];
#pragma unroll
        for (int kk = 0; kk < 2; ++kk)
#pragma unroll
            for (int n2 = 0; n2 < 2; ++n2) vb[kk][n2] = __builtin_bit_cast(bf16x8, VF[(kk * 2 + n2) * 64 + lane]);
        if (!isw) {
            bf16x8 vbo[2];
#pragma unroll
            for (int kk = 0; kk < 2; ++kk) vbo[kk] = __builtin_bit_cast(bf16x8, VF[(kk * 2 + nt) * 64 + lane]);
#pragma unroll
            for (int mi = 0; mi < 2; ++mi) {
#pragma unroll
                for (int kk = 0; kk < 2; ++kk) acc[mi] = __builtin_amdgcn_mfma_f32_16x16x32_bf16(ifr[mi][kk], vbo[kk], acc[mi], 0, 0, 0);
                bf16* op = OR + (size_t)(b * 2048 + c * 64 + 16 * (2 * xp + mi) + 4 * quad) * 1024 + h * 128 + 32 * vs + 16 * nt + fr;
#pragma unroll
                for (int e = 0; e < 4; ++e) op[(size_t)e * 1024] = (bf16)(pk2(acc[mi][e], 0.f) & 0xffff);
            }
        }
#pragma unroll
        for (int n2 = 0; n2 < 2; ++n2) {
            sacc[n2] = sacc[n2] * last;
#pragma unroll
            for (int kk = 0; kk < 2; ++kk) sacc[n2] = __builtin_amdgcn_mfma_f32_16x16x32_bf16(kf[kk], vb[kk][n2], sacc[n2], 0, 0, 0);
            *(LAS u32x2*)(ST + (16 * n2 + fr) * ST_LD + 16 * wave + 4 * quad) = (u32x2){pk2(sacc[n2][0], sacc[n2][1]), pk2(sacc[n2][2], sacc[n2][3])};
        }
        LDS_WAIT(); __builtin_amdgcn_s_barrier(); asm volatile("" ::: "memory");
    }
#undef SCAN_LOAD
}

struct Args { const float* in[21]; float* out; unsigned char* ws; int ph_lo, ph_hi; };
constexpr int PH_PER_LAYER = (REP_SP == 100) ? 12 : (REP_SP >= 0) ? 11 : 10, N_PHASES = 2 + NLAYER * PH_PER_LAYER;

__global__ void __launch_bounds__(NTHREADS, 2) mega_fwd(Args args) {
    extern __shared__ __attribute__((aligned(16))) unsigned char lds_raw[];
    Ctx C;
#pragma unroll
    for (int i = 0; i < 21; ++i) C.in[i] = args.in[i];
    C.out = args.out; C.ws = args.ws; C.lds = (LAS unsigned char*)lds_raw;
    C.G = gridDim.x; C.bid = blockIdx.x;
    cg::grid_group grid = cg::this_grid();
    volatile LAS unsigned* misc = (volatile LAS unsigned*)(C.lds + LDS_MISC);
    if (threadIdx.x < 4) misc[threadIdx.x] = 0u;
    __syncthreads();
    XcdBarrier xbar = xcd_barrier_post((unsigned*)(C.ws + WS_BAR), misc);
    for (int ph = args.ph_lo; ph < args.ph_hi; ++ph) {
        if (ph > args.ph_lo) { if (ph == 1) grid.sync(); else { XcdBarrier xb2 = xbar; asm volatile("" : "+s"(xb2.bar)); xcd_barrier(xb2); } }
        {
            typedef __attribute__((address_space(4))) const unsigned char* kptr_t;
            kptr_t kp = (kptr_t)__builtin_amdgcn_kernarg_segment_ptr(); asm volatile("" : "+s"(kp));
#pragma unroll
            for (int i = 0; i < 21; ++i) C.in[i] = *(const float* const __attribute__((address_space(4)))*)(kp + 8 * i);
            C.out = *(float* const __attribute__((address_space(4)))*)(kp + 168); C.ws = *(unsigned char* const __attribute__((address_space(4)))*)(kp + 176);
        }
        float* mod = (float*)(C.ws + WS_MOD);
        { int tid_ = threadIdx.x; asm volatile("" : "+v"(tid_)); C.tid = tid_; C.lane = tid_ & 63; C.wave = __builtin_amdgcn_readfirstlane(tid_ >> 6); }
        if (ph == 0) { phase_mod(C); phase_convert(C, 0); continue; }
        if (ph == 1) { phase_modulate(C, C.in[I_X], mod, 0, 1024, (bf16*)(C.ws + WS_A)); continue; }
        const int l = (ph - 2) / PH_PER_LAYER; int sp = (ph - 2) % PH_PER_LAYER; if (REP_SP == 100) { if (sp >= 2) sp -= 2; } else if (REP_SP >= 0 && sp > REP_SP) --sp;
        const float* modl = mod + (size_t)l * 8 * 6144;
        const float* Xres = (l == 0 && sp < 6) ? C.in[I_X] : C.out;
        switch (sp) {
#if PHM & 1
        case 0: {
            pg8::Gemm g{(const bf16*)(C.ws + WS_A), (const bf16*)(C.ws + WS_WIN), T_TOK, NPROJ, 1024}; pg8::StaticOrder S; S.init(T_TOK, NPROJ, C.G, C.bid);
            EpiProj E{C.ws}; pg8::gemm_phase<EpiProj, pg8::StaticOrder, true, true>(C.lds, g, S, E);
        } break;
#endif
#if PHM & 2
        case 1: { for (int u = C.bid; u < 2048; u += C.G) gdn_prep_unit(C, l, u); } break;
#endif
#if PHM & 4
        case 2: { for (int u = C.bid; u < 256; u += C.G) { const int su = (C.G == 256) ? (((u & 7) * 8 + (u >> 5)) * 4 + ((u >> 3) & 3)) : u; gdn_scan_unit(C, su); } } break;
#endif
#if PHM & 8
        case 3: { phase_attn_post(C, l); } break;
#endif
#if PHM & 16
        case 4: {
            pg8::StaticOrder S; S.init(T_TOK, 1024, C.G, C.bid);
            { pg8::Gemm g{(const bf16*)(C.ws + WS_A), (const bf16*)(C.ws + WS_WOA), T_TOK, 1024, 1024}; EpiGate<true> E{(const bf16*)(C.ws + WS_GA), (bf16*)(C.ws + WS_MP)};
              pg8::gemm_phase<EpiGate<true>, pg8::StaticOrder, true, true>(C.lds, g, S, E); }
            { pg8::Gemm g{(const bf16*)(C.ws + WS_GO), (const bf16*)(C.ws + WS_WOB), T_TOK, 1024, 1024}; EpiGate<false> E{(const bf16*)(C.ws + WS_GB), (bf16*)(C.ws + WS_MP)};
              pg8::gemm_phase<EpiGate<false>, pg8::StaticOrder, true, true>(C.lds, g, S, E); }
        } break;
#endif
#if PHM & 32
        case 5: {
            pg8::Gemm g{(const bf16*)(C.ws + WS_MP), (const bf16*)(C.ws + WS_WOUT), T_TOK, 1024, 1024}; pg8::StaticOrder S; S.init(T_TOK, 1024, C.G, C.bid);
            EpiResid E{Xres, (float*)(C.ws + WS_Y), modl + 2048, nullptr}; pg8::gemm_phase<EpiResid, pg8::StaticOrder, true, true>(C.lds, g, S, E);
        } break;
#endif
#if PHM & 64
        case 6: { phase_ln(C, (const float*)(C.ws + WS_Y), C.out, C.in[I_LN1G] + l * 1024, C.in[I_LN1B] + l * 1024, modl, 3072, 4096, (bf16*)(C.ws + WS_A)); } break;
#endif
#if PHM & 128
        case 7: {
            pg8::Gemm g{(const bf16*)(C.ws + WS_A), (const bf16*)(C.ws + WS_WFF1), T_TOK, DFF, 1024}; pg8::StaticOrder S; S.init(T_TOK, DFF, C.G, C.bid);
            EpiFF1 E{(bf16*)(C.ws + WS_H), C.in[I_BFF1] + l * DFF}; pg8::gemm_phase<EpiFF1, pg8::StaticOrder, true, true>(C.lds, g, S, E);
        } break;
#endif
#if PHM & 256
        case 8: {
            pg8::Gemm g{(const bf16*)(C.ws + WS_H), (const bf16*)(C.ws + WS_WFF2), T_TOK, 1024, DFF}; pg8::StaticOrder S; S.init(T_TOK, 1024, C.G, C.bid);
            EpiResid E{C.out, (float*)(C.ws + WS_Y), modl + 5120, C.in[I_BFF2] + l * 1024}; pg8::gemm_phase<EpiResid, pg8::StaticOrder, true, true>(C.lds, g, S, E);
        } break;
#endif
#if PHM & 512
        case 9: {
            const bool more = (l + 1 < NLAYER);
            phase_ln(C, (const float*)(C.ws + WS_Y), C.out, C.in[I_LN2G] + l * 1024, C.in[I_LN2B] + l * 1024, modl + 8 * 6144, 0, 1024, more ? (bf16*)(C.ws + WS_A) : (bf16*)nullptr);
            if (more) phase_convert(C, l + 1);
        } break;
#endif
        }
    }
}

#ifndef PHM
#define PHM 1023
#endif
#ifndef MK_PER_PHASE
#define MK_PER_PHASE 0
#endif
extern "C" void kernel_launch(void* const* d_in, const int* in_sizes, int n_in, void* d_out, int out_size, void* d_ws, size_t ws_size, hipStream_t stream) {
    static int grid = 0;
    if (grid == 0) {
        if (n_in != 21 || out_size != T_TOK * DM || ws_size < WS_END) { fprintf(stderr, "kernel_launch: unexpected shapes (n_in %d out %d ws %zu)\n", n_in, out_size, ws_size); grid = -1; return; }
        int dev = 0, cus = 0, per_cu = 0;
        hipGetDevice(&dev); hipDeviceGetAttribute(&cus, hipDeviceAttributeMultiprocessorCount, dev);
        hipFuncSetAttribute((const void*)mega_fwd, hipFuncAttributeMaxDynamicSharedMemorySize, LDS_BYTES);
        hipOccupancyMaxActiveBlocksPerMultiprocessor(&per_cu, (const void*)mega_fwd, NTHREADS, LDS_BYTES);
        if (per_cu < 1) per_cu = 1;
        (void)hipGetLastError();
        grid = cus * per_cu; if (grid > 256) grid = 256;
    }
    if (grid < 0) return;
    Args a{};
    for (int i = 0; i < 21; ++i) a.in[i] = (const float*)d_in[i];
    a.out = (float*)d_out; a.ws = (unsigned char*)d_ws;
#if MK_PER_PHASE
    for (int ph = 0; ph < N_PHASES; ++ph) { a.ph_lo = ph; a.ph_hi = ph + 1; hipLaunchKernelGGL(mega_fwd, dim3(grid), dim3(NTHREADS), LDS_BYTES, stream, a); }
#else
    (void)hipMemsetAsync((unsigned char*)d_ws + WS_BAR, 0, WS_BAR_BYTES, stream);
    a.ph_lo = 0; a.ph_hi = N_PHASES;
    void* kargs[] = {&a};
    hipError_t e = hipLaunchCooperativeKernel((const void*)mega_fwd, dim3(grid), dim3(NTHREADS), kargs, LDS_BYTES, stream);
    if (e != hipSuccess) fprintf(stderr, "cooperative launch failed: %s (grid %d)\n", hipGetErrorString(e), grid);
#endif
}
```

```cpp
#include <hip/hip_runtime.h>
#include <hip/hip_cooperative_groups.h>
#include <cstdio>
#include <cstdint>
namespace cg = cooperative_groups;
namespace pg8 {
#define PG8_LAS __attribute__((address_space(3)))
typedef unsigned short bf16_t;
typedef short bf16x8 __attribute__((ext_vector_type(8)));
typedef float f32x4 __attribute__((ext_vector_type(4)));
typedef unsigned u32x4 __attribute__((ext_vector_type(4)));
constexpr int BM = 256, BK = 64, HALF = 128, HTB = HALF * BK * 2  , STAGE_BYTES = 8 * HTB, NXCD = 8, WGM = 8;

__host__ __device__ __forceinline__ int lds_byte(int r, int c) { const int st = (r >> 4) * 2 + (c >> 5), rr = r & 15, cc = c & 31, ob = rr * 64 + cc * 2; return st * 1024 + (ob ^ (((ob >> 9) & 1) << 5)); }
__host__ __device__ __forceinline__ void stage_rc(int b, int& R, int& C) { const int st = b / 1024, sb = b % 1024, swz = sb ^ (((sb >> 9) & 1) << 5); R = (st >> 1) * 16 + swz / 64; C = (st & 1) * 32 + (swz % 64) / 2; }
__host__ __device__ __forceinline__ int perm32(int rho) { const int n = rho >> 4, i = rho & 15; return 8 * (i >> 2) + 4 * n + (i & 3); }

struct Unit { int pm, pn; };
struct Gemm { const bf16_t* A; const bf16_t* Bt; int M, N, K; };

struct StaticOrder {
    int nM, nN, nwg, G, c;
    __host__ __device__ void init(int M, int N, int G_, int c_) { nM = M / BM; nN = N / BM; nwg = nM * nN; G = G_; c = c_; }
    __host__ __device__ bool next(int i, Unit& u) const {
        const long L = (long)i * G + c; if (L >= nwg) return false;
        int wgid = (int)L; { const int q = nwg / NXCD, r = nwg % NXCD, xcd = wgid % NXCD, off = wgid / NXCD; wgid = (xcd < r ? xcd * (q + 1) : r * (q + 1) + (xcd - r) * q) + off; }
        const int nig = WGM * nN, gid = wgid / nig, fm = gid * WGM, gsz = (nM - fm) < WGM ? (nM - fm) : WGM;
        u.pm = fm + ((wgid % nig) % gsz); u.pn = (wgid % nig) / gsz; return true;
    }
    __device__ __forceinline__ void a_ready(const Unit&) const {}
    __device__ __forceinline__ void done(const Unit&) const {}
};

__device__ __forceinline__ unsigned cvt_pk_bf16(float lo, float hi) { unsigned r; asm volatile("v_cvt_pk_bf16_f32 %0, %1, %2" : "=v"(r) : "v"(lo), "v"(hi)); return r; }
typedef float f32x2 __attribute__((ext_vector_type(2)));
template <class Epi, class Sched, bool ALIGN_EPI = false, bool SP2 = false>
__device__ __forceinline__ void gemm_phase(PG8_LAS unsigned char* lds, const Gemm g, const Sched& S, const Epi& E) {
    int tid = threadIdx.x; asm volatile("" : "+v"(tid)); const int wid = __builtin_amdgcn_readfirstlane(tid >> 6), lane = tid & 63, wr = wid >> 2, wc = wid & 3, fr = lane & 15, fq = lane >> 4;
    const int K = g.K, nt = K / BK;
    unsigned voffA[2], voffB[2];
#pragma unroll
    for (int i = 0; i < 2; ++i) { int R, C; stage_rc(tid * 16 + i * 8192, R, C); const int Rb = Epi::PERM ? ((R & ~31) + perm32(R & 31)) : R;
        voffA[i] = (unsigned)(R * K + C) * 2u; voffB[i] = (unsigned)(Rb * K + C) * 2u; }
    const size_t kstep = (size_t)(BK * 2);
    const size_t hstep = (size_t)HALF * K * 2;
    const size_t tstep = 2 * hstep;
    const unsigned ldsw = (unsigned)wid * 1024u;
    const int aoff = lds_byte(wr * 64 + fr, fq * 8), boff = lds_byte(wc * 32 + fr, fq * 8);
#define PG8_SA(b, h) (((b) * 2 + (h)) * HTB)
#define PG8_SB(b, h) ((4 + (b) * 2 + (h)) * HTB)
#define PG8_STAGE(bufoff, gbase, voff) do { _Pragma("unroll") for (int _i = 0; _i < 2; ++_i) \
        __builtin_amdgcn_global_load_lds((const unsigned*)((const char*)(gbase) + (voff)[_i]), (PG8_LAS unsigned*)(lds + (bufoff) + ldsw + _i * 8192), 16, 0, 0); } while (0)
#define PG8_LDA(dst, b, h) do { _Pragma("unroll") for (int m = 0; m < 4; ++m) _Pragma("unroll") for (int k = 0; k < 2; ++k) dst[m][k] = *(const PG8_LAS bf16x8*)(lds + PG8_SA(b, h) + aoff + m * 2048 + k * 1024); } while (0)
#define PG8_LDB(dst, b, h) do { _Pragma("unroll") for (int n = 0; n < 2; ++n) _Pragma("unroll") for (int k = 0; k < 2; ++k) dst[n][k] = *(const PG8_LAS bf16x8*)(lds + PG8_SB(b, h) + boff + n * 2048 + k * 1024); } while (0)
#define PG8_MMA(ai, bj, At, Bt) do { __builtin_amdgcn_s_setprio(1); _Pragma("unroll") for (int m = 0; m < 4; ++m) _Pragma("unroll") for (int n = 0; n < 2; ++n) _Pragma("unroll") for (int k = 0; k < 2; ++k) \
        acc[ai][bj][m][n] = __builtin_amdgcn_mfma_f32_16x16x32_bf16(Bt[n][k], At[m][k], acc[ai][bj][m][n], 0, 0, 0); __builtin_amdgcn_s_setprio(0); } while (0)
#define PG8_WAIT_V(n) asm volatile("s_waitcnt vmcnt(" #n ")" ::: "memory")
#define PG8_WAIT_L(n) asm volatile("s_waitcnt lgkmcnt(" #n ")" ::: "memory")
#define PG8_BAR __builtin_amdgcn_s_barrier()
#define PG8_SCHED __builtin_amdgcn_sched_barrier(0)
    Unit cur, nxt; int ui = 0;
    if (!S.next(0, cur)) return;
    f32x4 acc[2][2][4][2];
#pragma unroll
    for (int a = 0; a < 2; ++a)
#pragma unroll
        for (int b = 0; b < 2; ++b)
#pragma unroll
            for (int m = 0; m < 4; ++m)
#pragma unroll
                for (int n = 0; n < 2; ++n) acc[a][b][m][n] = (f32x4){0.f, 0.f, 0.f, 0.f};
    bf16x8 At[4][2], B0[2][2], B1[2][2];
    const char* cA = (const char*)g.A + (size_t)cur.pm * tstep; const char* cB = (const char*)g.Bt + (size_t)cur.pn * tstep;
    S.a_ready(cur);
    if constexpr (SP2) {
        PG8_STAGE(PG8_SB(0, 0), cB, voffB); PG8_STAGE(PG8_SB(0, 1), cB + hstep, voffB); PG8_STAGE(PG8_SA(0, 0), cA, voffA); PG8_STAGE(PG8_SA(0, 1), cA + hstep, voffA);
        if (wr == 1) PG8_BAR;
        PG8_WAIT_V(2); PG8_BAR;
        PG8_STAGE(PG8_SB(1, 0), cB + kstep, voffB); PG8_STAGE(PG8_SA(1, 0), cA + kstep, voffA); PG8_STAGE(PG8_SB(1, 1), cB + hstep + kstep, voffB);
        PG8_WAIT_V(6); PG8_BAR;
    } else {
        PG8_STAGE(PG8_SB(0, 0), cB, voffB); PG8_STAGE(PG8_SA(0, 0), cA, voffA); PG8_STAGE(PG8_SB(0, 1), cB + hstep, voffB); PG8_STAGE(PG8_SA(0, 1), cA + hstep, voffA);
        if (wr == 1) PG8_BAR;
        PG8_WAIT_V(4); PG8_BAR;
        PG8_STAGE(PG8_SB(1, 0), cB + kstep, voffB); PG8_STAGE(PG8_SA(1, 0), cA + kstep, voffA); PG8_STAGE(PG8_SB(1, 1), cB + hstep + kstep, voffB);
        PG8_WAIT_V(6); PG8_BAR;
    }
    for (;;) {
        const bool has_next = S.next(ui + 1, nxt);
        const char* nA = has_next ? (const char*)g.A + (size_t)nxt.pm * tstep : cA; const char* nB = has_next ? (const char*)g.Bt + (size_t)nxt.pn * tstep : cB;
        for (int t = 0; t < nt; t += 2) {
            const bool last = (t == nt - 2);
            const char* a1 = cA + (size_t)(t + 1) * kstep;
            const char* a2 = last ? nA : cA + (size_t)(t + 2) * kstep; const char* b2 = last ? nB : cB + (size_t)(t + 2) * kstep;
            const char* a3 = a2 + kstep; const char* b3 = b2 + kstep;
            if (last && has_next) S.a_ready(nxt);
            if constexpr (SP2) {
            PG8_LDB(B0, 0, 0); PG8_LDB(B1, 0, 1); PG8_SCHED; PG8_LDA(At, 0, 0); PG8_STAGE(PG8_SA(1, 1), a1 + hstep, voffA);
            PG8_WAIT_V(8); PG8_WAIT_L(0); PG8_BAR; PG8_MMA(0, 0, At, B0); PG8_MMA(0, 1, At, B1); PG8_BAR; PG8_SCHED;
            PG8_LDA(At, 0, 1); PG8_STAGE(PG8_SB(0, 0), b2, voffB); PG8_STAGE(PG8_SB(0, 1), b2 + hstep, voffB); PG8_STAGE(PG8_SA(0, 0), a2, voffA);
            PG8_WAIT_V(8); PG8_WAIT_L(0); PG8_BAR; PG8_MMA(1, 0, At, B0); PG8_MMA(1, 1, At, B1); PG8_BAR; PG8_SCHED;
            PG8_LDB(B0, 1, 0); PG8_LDB(B1, 1, 1); PG8_SCHED; PG8_LDA(At, 1, 0); PG8_STAGE(PG8_SA(0, 1), a2 + hstep, voffA);
            PG8_WAIT_V(8); PG8_WAIT_L(0); PG8_BAR; PG8_MMA(0, 0, At, B0); PG8_MMA(0, 1, At, B1); PG8_BAR; PG8_SCHED;
            PG8_LDA(At, 1, 1); PG8_STAGE(PG8_SB(1, 0), b3, voffB); PG8_STAGE(PG8_SB(1, 1), b3 + hstep, voffB); PG8_STAGE(PG8_SA(1, 0), a3, voffA);
            PG8_WAIT_V(8); PG8_WAIT_L(0); PG8_BAR; PG8_MMA(1, 0, At, B0); PG8_MMA(1, 1, At, B1); PG8_BAR; PG8_SCHED;
            } else {
            PG8_LDB(B0, 0, 0); PG8_SCHED; PG8_LDA(At, 0, 0); PG8_STAGE(PG8_SA(1, 1), a1 + hstep, voffA);
            PG8_WAIT_L(8); PG8_BAR; PG8_WAIT_L(0); PG8_MMA(0, 0, At, B0); PG8_BAR; PG8_SCHED;
            PG8_LDB(B1, 0, 1); PG8_STAGE(PG8_SB(0, 0), b2, voffB);
            PG8_BAR; PG8_WAIT_L(0); PG8_MMA(0, 1, At, B1); PG8_BAR;
            PG8_LDA(At, 0, 1); PG8_STAGE(PG8_SA(0, 0), a2, voffA);
            PG8_BAR; PG8_WAIT_L(0); PG8_MMA(1, 0, At, B0); PG8_BAR; PG8_SCHED;
            PG8_STAGE(PG8_SB(0, 1), b2 + hstep, voffB);
            PG8_WAIT_V(6); PG8_BAR; PG8_MMA(1, 1, At, B1); PG8_BAR;
            PG8_LDB(B0, 1, 0); PG8_SCHED; PG8_LDA(At, 1, 0); PG8_STAGE(PG8_SA(0, 1), a2 + hstep, voffA);
            PG8_WAIT_L(8); PG8_BAR; PG8_WAIT_L(0); PG8_MMA(0, 0, At, B0); PG8_BAR; PG8_SCHED;
            PG8_LDB(B1, 1, 1); PG8_STAGE(PG8_SB(1, 0), b3, voffB);
            PG8_BAR; PG8_WAIT_L(0); PG8_MMA(0, 1, At, B1); PG8_BAR;
            PG8_LDA(At, 1, 1); PG8_STAGE(PG8_SA(1, 0), a3, voffA);
            PG8_BAR; PG8_WAIT_L(0); PG8_MMA(1, 0, At, B0); PG8_BAR; PG8_SCHED;
            PG8_STAGE(PG8_SB(1, 1), b3 + hstep, voffB);
            PG8_WAIT_V(6); PG8_BAR; PG8_MMA(1, 1, At, B1); PG8_BAR;
            }
        }
        if constexpr (ALIGN_EPI) { if (wr == 0) PG8_BAR; }
        if constexpr (!Epi::AFTER_DRAIN) { E(acc, cur, wr, wc, fr, fq); S.done(cur); }
        if (!has_next) break;
#pragma unroll
        for (int a = 0; a < 2; ++a)
#pragma unroll
            for (int b = 0; b < 2; ++b)
#pragma unroll
                for (int m = 0; m < 4; ++m)
#pragma unroll
                    for (int n = 0; n < 2; ++n) acc[a][b][m][n] = (f32x4){0.f, 0.f, 0.f, 0.f};
        cur = nxt; cA = nA; cB = nB; ++ui;
        if constexpr (ALIGN_EPI) { if (wr == 1) PG8_BAR; }
    }
    PG8_WAIT_V(0);
    if constexpr (!ALIGN_EPI) { if (wr == 0) PG8_BAR; }
    PG8_BAR;
    if constexpr (Epi::AFTER_DRAIN) { E.fused(acc, cur, wr, wc, fr, fq, lds, wid, lane); S.done(cur); }
#undef PG8_SA
#undef PG8_SB
#undef PG8_STAGE
#undef PG8_LDA
#undef PG8_LDB
#undef PG8_MMA
#undef PG8_WAIT_V
#undef PG8_WAIT_L
#undef PG8_BAR
#undef PG8_SCHED
}
}

#ifndef PHM
#define PHM 1023
#endif
#ifndef REP_SP
#define REP_SP -1
#endif
#define LAS __attribute__((address_space(3)))
typedef unsigned short bf16;
typedef float f32x4 __attribute__((ext_vector_type(4)));
typedef float f32x16 __attribute__((ext_vector_type(16)));
typedef short bf16x8 __attribute__((ext_vector_type(8)));
typedef unsigned u32x4 __attribute__((ext_vector_type(4)));
typedef unsigned u32x2 __attribute__((ext_vector_type(2)));

constexpr int T_TOK = 16384, DM = 1024, SEQ = 2048, NLAYER = 4, DFF = 4096, NPROJ = 7936, DIN = 7696;
constexpr float ALPHA_DN = 1.6817928305074290f;
constexpr float LN_EPS = 1e-5f, RMS_EPS = 1e-6f;
constexpr int NTHREADS = 512;
constexpr int LDS_BYTES = 135424, LDS_MISC = 135168;

constexpr size_t MiB = (size_t)1 << 20;
constexpr size_t WS_MOD = 0, WS_BA = 1 * MiB, WS_HALO = 2 * MiB, WS_LAST = 7 * MiB, WS_BAR = 7 * MiB + 512 * 1024, WS_BAR_BYTES = 16384, WS_W = 8 * MiB;
constexpr size_t WS_WIN = WS_W, WS_WOA = WS_W + 16 * MiB, WS_WOB = WS_W + 18 * MiB, WS_WOUT = WS_W + 20 * MiB, WS_WFF1 = WS_W + 22 * MiB, WS_WFF2 = WS_W + 30 * MiB;
constexpr size_t WS_A = 46 * MiB, WS_GO = 78 * MiB, WS_WG = 110 * MiB, WS_INTRA = 142 * MiB, WS_OR = 158 * MiB, WS_PROJ = 190 * MiB;
constexpr size_t WS_Q = WS_PROJ, WS_K = WS_PROJ + 32 * MiB, WS_VT = WS_PROJ + 40 * MiB, WS_DQ = WS_PROJ + 48 * MiB, WS_DK = WS_PROJ + 80 * MiB, WS_DV = WS_PROJ + 112 * MiB;
constexpr size_t WS_Z = WS_PROJ + 144 * MiB, WS_GA = WS_PROJ + 176 * MiB, WS_GB = WS_PROJ + 208 * MiB, WS_END = WS_PROJ + 240 * MiB;
constexpr size_t WS_MP = WS_PROJ, WS_H = WS_PROJ, WS_Y = WS_PROJ + 128 * MiB;

__device__ __forceinline__ float bf2f(unsigned h) { return __uint_as_float(h << 16); }
typedef float f32x2_t __attribute__((ext_vector_type(2))); typedef __bf16 bf16x2_t __attribute__((ext_vector_type(2)));
__device__ __forceinline__ unsigned pk2(float lo, float hi) { f32x2_t v = {lo, hi}; bf16x2_t b = __builtin_convertvector(v, bf16x2_t); return __builtin_bit_cast(unsigned, b); }
__device__ __forceinline__ float sigm(float x) { return __builtin_amdgcn_rcpf(1.f + __expf(-x)); }
__device__ __forceinline__ float siluf(float x) { return x * __builtin_amdgcn_rcpf(1.f + __expf(-x)); }
#define LDS_WAIT() asm volatile("s_waitcnt lgkmcnt(0)" ::: "memory")
#define LDS_BAR() do { asm volatile("s_waitcnt lgkmcnt(0)" ::: "memory"); __builtin_amdgcn_s_barrier(); asm volatile("" ::: "memory"); } while (0)
__device__ __forceinline__ float shx(float v, int m, int lane) { return __int_as_float(__builtin_amdgcn_ds_bpermute((lane ^ m) << 2, __float_as_int(v))); }
__device__ __forceinline__ float shup(float v, int o, int lane) { return __int_as_float(__builtin_amdgcn_ds_bpermute((lane - o) << 2, __float_as_int(v))); }

#define XB_TMO      128
#define XB_XCNT(j)  (256  + 64 * (j))
#define XB_XSUB(j)  (1280 + 64 * (j))
#define XB_XGEN(j)  (2304 + 64 * (j))
#define XB_TOP      3328
#define XB_TOPGEN   3392
#define XCD_BAR_WORDS 3456
#define XB_SPIN_CAP (1u << 18)

__device__ __forceinline__ unsigned xb_ld(unsigned* p)              { return __hip_atomic_load(p, __ATOMIC_RELAXED, __HIP_MEMORY_SCOPE_AGENT); }
__device__ __forceinline__ unsigned xb_add(unsigned* p, unsigned v) { return __hip_atomic_fetch_add(p, v, __ATOMIC_RELAXED, __HIP_MEMORY_SCOPE_AGENT); }
__device__ __forceinline__ unsigned xb_xcc_id() { return (unsigned)__builtin_amdgcn_s_getreg((3 << 11) | 20) & 0xFu; }
#define XB_SPIN(cond, bar) do { unsigned _sp = 0; while (cond) { __builtin_amdgcn_s_sleep(1); \
    if ((++_sp & 255u) == 0u) { if (xb_ld(&(bar)[XB_TMO])) break; if (_sp > XB_SPIN_CAP) { atomicAdd(&(bar)[XB_TMO], 1u); break; } } } } while (0)

struct XcdBarrier {
    unsigned* bar; unsigned x;
    volatile LAS unsigned* st;
};

__device__ __forceinline__ XcdBarrier xcd_barrier_post(unsigned* bar, volatile LAS unsigned* st) {
    XcdBarrier b; b.bar = bar; b.x = xb_xcc_id(); b.st = st;
    if (threadIdx.x == 0) (void)xb_add(&bar[XB_XCNT(b.x)], 1u);
    return b;
}
__device__ __forceinline__ void xcd_barrier_complete(unsigned* bar, unsigned x, unsigned& nloc, unsigned& nx) {
    const unsigned G = gridDim.x * gridDim.y * gridDim.z;
    unsigned sum, cnt, mine, sp = 0u;
    for (;;) {
        sum = 0u; cnt = 0u; mine = 0u;
#pragma unroll
        for (unsigned j = 0; j < 16; ++j) { const unsigned c = xb_ld(&bar[XB_XCNT(j)]); sum += c; cnt += (c > 0u) ? 1u : 0u; mine = (j == x) ? c : mine; }
        if (sum == G) break;
        __builtin_amdgcn_s_sleep(1);
        if ((++sp & 255u) == 0u) { if (xb_ld(&bar[XB_TMO])) break; if (sp > XB_SPIN_CAP) { atomicAdd(&bar[XB_TMO], 1u); break; } }
    }
    nloc = mine > 0u ? mine : 1u; nx = cnt > 0u ? cnt : 1u;
}

__device__ __forceinline__ void xcd_barrier(const XcdBarrier& b) {
    asm volatile("s_waitcnt vmcnt(0)" ::: "memory");
    __syncthreads();
    if (threadIdx.x == 0) {
        unsigned* bar = b.bar;
        __builtin_amdgcn_s_waitcnt(0);
        unsigned nloc = b.st[0], nx = b.st[1];
        if (nloc == 0u) { xcd_barrier_complete(bar, b.x, nloc, nx); b.st[0] = nloc; b.st[1] = nx; }
        const unsigned old = xb_add(&bar[XB_XSUB(b.x)], 1u);
        const unsigned gen = old / nloc;
        if (old + 1u == (gen + 1u) * nloc) {
            __builtin_amdgcn_fence(__ATOMIC_RELEASE, "agent");
            asm volatile("s_waitcnt vmcnt(0)" ::: "memory");
            const unsigned og = xb_add(&bar[XB_TOP], 1u);
            const unsigned tg = og / nx;
            if (og + 1u == (tg + 1u) * nx) xb_add(&bar[XB_TOPGEN], 1u);
            else XB_SPIN(xb_ld(&bar[XB_TOPGEN]) == tg, bar);
            __builtin_amdgcn_fence(__ATOMIC_ACQUIRE, "agent");
            xb_add(&bar[XB_XGEN(b.x)], 1u);
            asm volatile("s_waitcnt vmcnt(0)" ::: "memory");
        } else {
            XB_SPIN(xb_ld(&bar[XB_XGEN(b.x)]) == gen, bar);
            __builtin_amdgcn_fence(__ATOMIC_ACQUIRE, "agent");
            asm volatile("s_waitcnt vmcnt(0)" ::: "memory");
        }
    }
    __syncthreads();
}

struct EpiProj {
    static constexpr bool PERM = true, AFTER_DRAIN = false;
    unsigned char* ws;
    __device__ __forceinline__ void operator()(const f32x4 (&acc)[2][2][4][2], const pg8::Unit& u, int wr, int wc, int fr, int fq) const {
        const int pn = u.pn; const int row0 = u.pm * 256 + wr * 64 + fr; const int cl0 = wc * 32 + 8 * fq;
#pragma unroll
        for (int ai = 0; ai < 2; ++ai)
#pragma unroll
            for (int m = 0; m < 4; ++m) {
                const int row = row0 + ai * 128 + m * 16;
#pragma unroll
                for (int bj = 0; bj < 2; ++bj) {
                    const int cl = cl0 + bj * 128; const f32x4 v0 = acc[ai][bj][m][0], v1 = acc[ai][bj][m][1];
                    u32x4 w; w.x = pk2(v0[0], v0[1]); w.y = pk2(v0[2], v0[3]); w.z = pk2(v1[0], v1[1]); w.w = pk2(v1[2], v1[3]);
                    if (pn < 4) { *(u32x4*)((bf16*)(ws + WS_Q) + (size_t)row * 1024 + pn * 256 + cl) = w; }
                    else if (pn == 4) { *(u32x4*)((bf16*)(ws + WS_K) + (size_t)row * 256 + cl) = w; }
                    else if (pn == 5) {
                        const int kvh = cl >> 6, d = cl & 63, b = row >> 11, s = row & 2047;
                        bf16* p = (bf16*)(ws + WS_VT) + ((size_t)((b * 4 + kvh) * 64 + d)) * 2048 + s;
                        p[0 * 2048] = (bf16)(w.x & 0xffff); p[1 * 2048] = (bf16)(w.x >> 16); p[2 * 2048] = (bf16)(w.y & 0xffff); p[3 * 2048] = (bf16)(w.y >> 16);
                        p[4 * 2048] = (bf16)(w.z & 0xffff); p[5 * 2048] = (bf16)(w.z >> 16); p[6 * 2048] = (bf16)(w.w & 0xffff); p[7 * 2048] = (bf16)(w.w >> 16);
                    }
                    else if (pn < 18) {
                        const int tsr = (pn - 6) >> 2, col = ((pn - 6) & 3) * 256 + cl, h = col >> 7, unit = (row >> 6) * 8 + h;
                        *(u32x4*)((bf16*)(ws + WS_DQ + (size_t)tsr * 32 * MiB) + (size_t)unit * 8192 + (row & 63) * 128 + (col & 127)) = w;
                        if ((row & 63) >= 61) *(u32x4*)((bf16*)(ws + WS_HALO) + ((size_t)(row >> 6) * 3 + ((row & 63) - 61)) * 3072 + tsr * 1024 + col) = w;
                    }
                    else if (pn < 30) {
                        const int tsr = (pn - 18) >> 2, col = ((pn - 18) & 3) * 256 + cl;
                        *(u32x4*)((bf16*)(ws + WS_Z + (size_t)tsr * 32 * MiB) + (size_t)row * 1024 + col) = w;
                    }
                    else if (cl < 16) { float* p = (float*)(ws + WS_BA) + (size_t)row * 16 + cl; *(f32x4*)p = v0; *(f32x4*)(p + 4) = v1; }
                }
            }
    }
};
template <bool FIRST> struct EpiGate {
    static constexpr bool PERM = true, AFTER_DRAIN = false;
    const bf16* G; bf16* MP;
    __device__ __forceinline__ void operator()(const f32x4 (&acc)[2][2][4][2], const pg8::Unit& u, int wr, int wc, int fr, int fq) const {
        const int row0 = u.pm * 256 + wr * 64 + fr; const int col0 = u.pn * 256 + wc * 32 + 8 * fq;
#pragma unroll
        for (int ai = 0; ai < 2; ++ai)
#pragma unroll
            for (int m = 0; m < 4; ++m) {
                const int row = row0 + ai * 128 + m * 16;
#pragma unroll
                for (int bj = 0; bj < 2; ++bj) {
                    const size_t idx = (size_t)row * 1024 + col0 + bj * 128; const f32x4 v0 = acc[ai][bj][m][0], v1 = acc[ai][bj][m][1];
                    const u32x4 g = *(const u32x4*)(G + idx);
                    float r[8];
                    r[0] = sigm(bf2f(g.x & 0xffff)) * v0[0]; r[1] = sigm(bf2f(g.x >> 16)) * v0[1]; r[2] = sigm(bf2f(g.y & 0xffff)) * v0[2]; r[3] = sigm(bf2f(g.y >> 16)) * v0[3];
                    r[4] = sigm(bf2f(g.z & 0xffff)) * v1[0]; r[5] = sigm(bf2f(g.z >> 16)) * v1[1]; r[6] = sigm(bf2f(g.w & 0xffff)) * v1[2]; r[7] = sigm(bf2f(g.w >> 16)) * v1[3];
                    if (!FIRST) { const u32x4 p = *(const u32x4*)(MP + idx);
                        r[0] += bf2f(p.x & 0xffff); r[1] += bf2f(p.x >> 16); r[2] += bf2f(p.y & 0xffff); r[3] += bf2f(p.y >> 16);
                        r[4] += bf2f(p.z & 0xffff); r[5] += bf2f(p.z >> 16); r[6] += bf2f(p.w & 0xffff); r[7] += bf2f(p.w >> 16); }
                    u32x4 w; w.x = pk2(r[0], r[1]); w.y = pk2(r[2], r[3]); w.z = pk2(r[4], r[5]); w.w = pk2(r[6], r[7]);
                    *(u32x4*)(MP + idx) = w;
                }
            }
    }
};
struct EpiResid {
    static constexpr bool PERM = true, AFTER_DRAIN = false;
    const float* X; float* Y; const float* gt; const float* bias;
    __device__ __forceinline__ void operator()(const f32x4 (&acc)[2][2][4][2], const pg8::Unit& u, int wr, int wc, int fr, int fq) const {
        const int row0 = u.pm * 256 + wr * 64 + fr; const int col0 = u.pn * 256 + wc * 32 + 8 * fq; const int b = u.pm >> 3;
#pragma unroll
        for (int bj = 0; bj < 2; ++bj) {
            const int col = col0 + bj * 128;
            f32x4 g0 = *(const f32x4*)(gt + b * 6144 + col) + 1.0f, g1 = *(const f32x4*)(gt + b * 6144 + col + 4) + 1.0f;
            f32x4 b0 = (f32x4){0.f, 0.f, 0.f, 0.f}, b1 = b0; if (bias) { b0 = *(const f32x4*)(bias + col); b1 = *(const f32x4*)(bias + col + 4); }
#pragma unroll
            for (int ai = 0; ai < 2; ++ai)
#pragma unroll
                for (int m = 0; m < 4; ++m) {
                    const size_t idx = (size_t)(row0 + ai * 128 + m * 16) * 1024 + col;
                    const f32x4 x0 = *(const f32x4*)(X + idx), x1 = *(const f32x4*)(X + idx + 4);
                    *(f32x4*)(Y + idx) = x0 * ALPHA_DN + g0 * (acc[ai][bj][m][0] + b0);
                    *(f32x4*)(Y + idx + 4) = x1 * ALPHA_DN + g1 * (acc[ai][bj][m][1] + b1);
                }
        }
    }
};
struct EpiFF1 {
    static constexpr bool PERM = true, AFTER_DRAIN = false;
    bf16* H; const float* bias;
    __device__ __forceinline__ void operator()(const f32x4 (&acc)[2][2][4][2], const pg8::Unit& u, int wr, int wc, int fr, int fq) const {
        const int row0 = u.pm * 256 + wr * 64 + fr; const int col0 = u.pn * 256 + wc * 32 + 8 * fq;
#pragma unroll
        for (int bj = 0; bj < 2; ++bj) {
            const int col = col0 + bj * 128;
            const f32x4 b0 = *(const f32x4*)(bias + col), b1 = *(const f32x4*)(bias + col + 4);
#pragma unroll
            for (int ai = 0; ai < 2; ++ai)
#pragma unroll
                for (int m = 0; m < 4; ++m) {
                    f32x4 v0 = acc[ai][bj][m][0] + b0, v1 = acc[ai][bj][m][1] + b1;
#pragma unroll
                    for (int e = 0; e < 4; ++e) { v0[e] = fmaxf(v0[e], 0.f); v0[e] *= v0[e]; v1[e] = fmaxf(v1[e], 0.f); v1[e] *= v1[e]; }
                    u32x4 w; w.x = pk2(v0[0], v0[1]); w.y = pk2(v0[2], v0[3]); w.z = pk2(v1[0], v1[1]); w.w = pk2(v1[2], v1[3]);
                    *(u32x4*)(H + (size_t)(row0 + ai * 128 + m * 16) * 4096 + col) = w;
                }
        }
    }
};

struct Ctx {
    const float* in[21]; float* out; unsigned char* ws;
    LAS unsigned char* lds; int tid, lane, wave, G, bid;
};
enum { I_X = 0, I_C, I_WADA, I_BADA, I_WIN, I_CONVW, I_ALOG, I_DTB, I_SINKS, I_DNW, I_WOA, I_WOB, I_WOUT, I_LN1G, I_LN1B, I_WFF1, I_BFF1, I_WFF2, I_BFF2, I_LN2G, I_LN2B };

__device__ __forceinline__ void phase_mod(const Ctx& C) {
    LAS float* cact = (LAS float*)C.lds;
    LAS float* red = (LAS float*)(C.lds + 32768);
    for (int i = C.tid; i < 8192; i += NTHREADS) cact[i] = siluf(C.in[I_C][i]);
    __syncthreads();
    float* mod = (float*)(C.ws + WS_MOD);
    for (int unit = C.bid; unit < 384; unit += C.G) {
        const int l = unit / 96, n0 = (unit % 96) * 64;
        const float* W = C.in[I_WADA] + (size_t)l * 1024 * 6144 + n0 + C.lane;
        float a[8];
#pragma unroll
        for (int b = 0; b < 8; ++b) a[b] = 0.f;
        const int k0 = C.wave * 128;
#pragma unroll 4
        for (int k = k0; k < k0 + 128; ++k) { const float w = W[(size_t)k * 6144];
#pragma unroll
            for (int b = 0; b < 8; ++b) a[b] += cact[b * 1024 + k] * w; }
#pragma unroll
        for (int b = 0; b < 8; ++b) red[(C.wave * 8 + b) * 64 + C.lane] = a[b];
        __syncthreads();
        { const int b = C.tid >> 6, ln = C.tid & 63; float s = 0.f;
#pragma unroll
          for (int w = 0; w < 8; ++w) s += red[(w * 8 + b) * 64 + ln];
          mod[(size_t)(l * 8 + b) * 6144 + n0 + ln] = s + C.in[I_BADA][l * 6144 + n0 + ln]; }
        __syncthreads();
    }
}

__device__ __forceinline__ int win_src_col(int n) { return n < 5632 ? n : (n < 7680 ? n + 16 : (n < 7696 ? n - 7680 + 5632 : -1)); }
__device__ __forceinline__ void tr_item(const float* W, int K, int N, bf16* WT, LAS float* scr, int item, int nblk, int lane, bool winmap) {
    const int kb = item / nblk, nb = item % nblk, k0 = 64 * kb, n0 = 32 * nb;
    const int n = n0 + (lane & 31); const int sc = winmap ? win_src_col(n) : n;
#pragma unroll 8
    for (int i = 0; i < 32; ++i) { const int kk = 2 * i + (lane >> 5); scr[kk * 33 + (lane & 31)] = (sc >= 0) ? W[(size_t)(k0 + kk) * N + sc] : 0.f; }
    LDS_WAIT();
    const int c = lane & 7;
#pragma unroll
    for (int j = 0; j < 4; ++j) { const int nn = (lane >> 3) + 8 * j; const LAS float* s = scr + (8 * c) * 33 + nn;
        u32x4 o; o.x = pk2(s[0 * 33], s[1 * 33]); o.y = pk2(s[2 * 33], s[3 * 33]); o.z = pk2(s[4 * 33], s[5 * 33]); o.w = pk2(s[6 * 33], s[7 * 33]);
        *(u32x4*)(WT + (size_t)(n0 + nn) * K + k0 + 8 * c) = o; }
    LDS_WAIT();
}
__device__ __forceinline__ void phase_convert(const Ctx& C, int l) {
    LAS float* scr = (LAS float*)(C.lds + 65536 + C.wave * 8704);
    const int gw = C.bid * 8 + C.wave, NGW = C.G * 8;
    constexpr int I_IN = 16 * 248, I_O = 16 * 32, I_1 = 16 * 128, I_2 = 64 * 32;
    constexpr int NIT = I_IN + 3 * I_O + I_1 + I_2;
    for (int it = gw; it < NIT; it += NGW) {
        int r = it;
        if (r < I_IN) { tr_item(C.in[I_WIN] + (size_t)l * 1024 * DIN, 1024, DIN, (bf16*)(C.ws + WS_WIN), scr, r, 248, C.lane, true); continue; } r -= I_IN;
        if (r < I_O) { tr_item(C.in[I_WOA] + (size_t)l * 1024 * 1024, 1024, 1024, (bf16*)(C.ws + WS_WOA), scr, r, 32, C.lane, false); continue; } r -= I_O;
        if (r < I_O) { tr_item(C.in[I_WOB] + (size_t)l * 1024 * 1024, 1024, 1024, (bf16*)(C.ws + WS_WOB), scr, r, 32, C.lane, false); continue; } r -= I_O;
        if (r < I_O) { tr_item(C.in[I_WOUT] + (size_t)l * 1024 * 1024, 1024, 1024, (bf16*)(C.ws + WS_WOUT), scr, r, 32, C.lane, false); continue; } r -= I_O;
        if (r < I_1) { tr_item(C.in[I_WFF1] + (size_t)l * 1024 * 4096, 1024, 4096, (bf16*)(C.ws + WS_WFF1), scr, r, 128, C.lane, false); continue; } r -= I_1;
        tr_item(C.in[I_WFF2] + (size_t)l * 4096 * 1024, 4096, 1024, (bf16*)(C.ws + WS_WFF2), scr, r, 32, C.lane, false);
    }
}

__device__ __forceinline__ float wave_sum(float v, int lane) {
#pragma unroll
    for (int o = 1; o < 64; o <<= 1) v += shx(v, o, lane);
    return v;
}
__device__ __forceinline__ void phase_modulate(const Ctx& C, const float* X, const float* modl  , int shoff, int scoff, bf16* U) {
    const int gw = C.bid * 8 + C.wave, NGW = C.G * 8;
    for (int row = gw; row < T_TOK; row += NGW) {
        const int b = row >> 11; const float* mb = modl + b * 6144;
#pragma unroll
        for (int j = 0; j < 4; ++j) { const int col = 4 * C.lane + 256 * j;
            const f32x4 x = *(const f32x4*)(X + (size_t)row * 1024 + col), sc = *(const f32x4*)(mb + scoff + col), sh = *(const f32x4*)(mb + shoff + col);
            const f32x4 u = x * (sc + 1.0f) + sh; u32x2 w; w.x = pk2(u[0], u[1]); w.y = pk2(u[2], u[3]);
            *(u32x2*)(U + (size_t)row * 1024 + col) = w; }
    }
}
__device__ __forceinline__ void phase_ln(const Ctx& C, const float* Y, float* X, const float* g, const float* bta, const float* modn, int shoff, int scoff, bf16* U) {
    const int gw = C.bid * 8 + C.wave, NGW = C.G * 8;
    for (int row0 = gw; row0 < T_TOK; row0 += 2 * NGW) {
        f32x4 v[2][4]; float s[2], s2[2], mean[2], rstd[2];
#pragma unroll
        for (int r = 0; r < 2; ++r) { const int row = row0 + r * NGW; s[r] = 0.f;
#pragma unroll
            for (int j = 0; j < 4; ++j) { v[r][j] = *(const f32x4*)(Y + (size_t)row * 1024 + 4 * C.lane + 256 * j); s[r] += (v[r][j][0] + v[r][j][1]) + (v[r][j][2] + v[r][j][3]); } }
#pragma unroll
        for (int r = 0; r < 2; ++r) { mean[r] = wave_sum(s[r], C.lane) * (1.f / 1024.f); s2[r] = 0.f;
#pragma unroll
            for (int j = 0; j < 4; ++j) { v[r][j] = v[r][j] - mean[r]; s2[r] += (v[r][j][0] * v[r][j][0] + v[r][j][1] * v[r][j][1]) + (v[r][j][2] * v[r][j][2] + v[r][j][3] * v[r][j][3]); } }
#pragma unroll
        for (int r = 0; r < 2; ++r) rstd[r] = 1.f / sqrtf(wave_sum(s2[r], C.lane) * (1.f / 1024.f) + LN_EPS);
#pragma unroll
        for (int r = 0; r < 2; ++r) { const int row = row0 + r * NGW; const int b = row >> 11;
#pragma unroll
            for (int j = 0; j < 4; ++j) { const int col = 4 * C.lane + 256 * j;
                const f32x4 x = v[r][j] * rstd[r] * *(const f32x4*)(g + col) + *(const f32x4*)(bta + col);
                *(f32x4*)(X + (size_t)row * 1024 + col) = x;
                if (U) { const float* mb = modn + b * 6144; const f32x4 sc = *(const f32x4*)(mb + scoff + col), sh = *(const f32x4*)(mb + shoff + col);
                    const f32x4 u = x * (sc + 1.0f) + sh; u32x2 w; w.x = pk2(u[0], u[1]); w.y = pk2(u[2], u[3]);
                    *(u32x2*)(U + (size_t)row * 1024 + col) = w; }
            } }
    }
}

__device__ __forceinline__ void attn_unit(const bf16* Q, const bf16* K, const bf16* VT, bf16* AO, float sink, int b, int h, int qt, int lane) {
    const int q = lane & 31, hi = lane >> 5, kvh = h >> 2, q0 = qt * 32;
    const bf16* qp = Q + (size_t)(b * 2048 + q0 + q) * 1024 + h * 64 + hi * 8;
    bf16x8 qf[4];
#pragma unroll
    for (int d0 = 0; d0 < 4; ++d0) qf[d0] = *(const bf16x8*)(qp + d0 * 16);
    const int pi = (q & 0x13) | ((q & 8) >> 1) | ((q & 4) << 1);
    const int jmin = (qt >= 4) ? 0 : (4 - qt);
    bf16x8 kf[5][4];
#pragma unroll
    for (int j = 0; j < 5; ++j) {
        const int kv0 = (j >= jmin) ? q0 - 128 + 32 * j : 0;
        const bf16* kp = K + (size_t)(b * 2048 + kv0 + pi) * 256 + kvh * 64 + hi * 8;
#pragma unroll
        for (int d0 = 0; d0 < 4; ++d0) kf[j][d0] = *(const bf16x8*)(kp + d0 * 16);
    }
    f32x16 s[5];
#pragma unroll
    for (int j = 0; j < 5; ++j) {
        f32x16 a;
#pragma unroll
        for (int r = 0; r < 16; ++r) a[r] = 0.f;
#pragma unroll
        for (int d0 = 0; d0 < 4; ++d0) a = __builtin_amdgcn_mfma_f32_32x32x16_bf16(kf[j][d0], qf[d0], a, 0, 0, 0);
        s[j] = a;
    }
    bf16x8 vf[5][2][2];
#pragma unroll
    for (int j = 0; j < 5; ++j) {
        const int kv0 = (j >= jmin) ? q0 - 128 + 32 * j : 0;
#pragma unroll
        for (int sl = 0; sl < 2; ++sl)
#pragma unroll
            for (int dh = 0; dh < 2; ++dh) vf[j][sl][dh] = *(const bf16x8*)(VT + ((size_t)((b * 4 + kvh) * 64 + 32 * dh + q)) * 2048 + kv0 + 16 * sl + 8 * hi);
    }
    float m = sink;
#pragma unroll
    for (int j = 0; j < 5; ++j)
#pragma unroll
        for (int r = 0; r < 16; ++r) {
            const int off = 16 * (r >> 3) + 8 * hi + (r & 7);
            bool valid = (j >= jmin);
            if (j == 0) valid = valid && (off > q);
            if (j == 4) valid = valid && (off <= q);
            const float v = valid ? s[j][r] * 0.125f : -INFINITY;
            s[j][r] = v; m = fmaxf(m, v);
        }
    m = fmaxf(m, shx(m, 32, lane));
    float sum = 0.f;
#pragma unroll
    for (int j = 0; j < 5; ++j)
#pragma unroll
        for (int r = 0; r < 16; ++r) { const float p = __expf(s[j][r] - m); s[j][r] = p; sum += p; }
    sum += shx(sum, 32, lane);
    const float inv = 1.f / (sum + __expf(sink - m));
    f32x16 o[2];
#pragma unroll
    for (int dh = 0; dh < 2; ++dh)
#pragma unroll
        for (int r = 0; r < 16; ++r) o[dh][r] = 0.f;
#pragma unroll
    for (int j = 0; j < 5; ++j) {
#pragma unroll
        for (int sl = 0; sl < 2; ++sl) {
            u32x4 pw; pw.x = pk2(s[j][8 * sl + 0] * inv, s[j][8 * sl + 1] * inv); pw.y = pk2(s[j][8 * sl + 2] * inv, s[j][8 * sl + 3] * inv);
            pw.z = pk2(s[j][8 * sl + 4] * inv, s[j][8 * sl + 5] * inv); pw.w = pk2(s[j][8 * sl + 6] * inv, s[j][8 * sl + 7] * inv);
            const bf16x8 pf = __builtin_bit_cast(bf16x8, pw);
#pragma unroll
            for (int dh = 0; dh < 2; ++dh) o[dh] = __builtin_amdgcn_mfma_f32_32x32x16_bf16(vf[j][sl][dh], pf, o[dh], 0, 0, 0);
        }
    }
    bf16* op = AO + (size_t)(b * 2048 + q0 + q) * 1024 + h * 64;
#pragma unroll
    for (int dh = 0; dh < 2; ++dh)
#pragma unroll
        for (int rr = 0; rr < 4; ++rr) { u32x2 w; w.x = pk2(o[dh][4 * rr + 0], o[dh][4 * rr + 1]); w.y = pk2(o[dh][4 * rr + 2], o[dh][4 * rr + 3]);
            *(u32x2*)(op + 32 * dh + 8 * rr + 4 * hi) = w; }
}
__device__ __forceinline__ void phase_attn_post(const Ctx& C, int l) {
    const int gw = C.bid * 8 + C.wave, NGW = C.G * 8;
    const bf16* Q = (const bf16*)(C.ws + WS_Q); const bf16* K = (const bf16*)(C.ws + WS_K); const bf16* VT = (const bf16*)(C.ws + WS_VT); bf16* AO = (bf16*)(C.ws + WS_A);
    for (int u = gw; u < 8192; u += NGW) {
        const int hg = u & 3, qt = (u >> 2) & 63, kvh = (u >> 8) & 3, b = u >> 10; const int h = kvh * 4 + hg;
        attn_unit(Q, K, VT, AO, C.in[I_SINKS][l * 16 + h], b, h, qt, C.lane);
    }
    const bf16* OR = (const bf16*)(C.ws + WS_OR); const bf16* Z = (const bf16*)(C.ws + WS_Z); bf16* GO = (bf16*)(C.ws + WS_GO);
    const float* nw = C.in[I_DNW] + l * 128 + (C.lane & 7) * 16;
    for (int row = gw; row < T_TOK; row += NGW) {
        const size_t idx = (size_t)row * 1024 + C.lane * 16;
        const u32x4 o0 = *(const u32x4*)(OR + idx), o1 = *(const u32x4*)(OR + idx + 8), z0 = *(const u32x4*)(Z + idx), z1 = *(const u32x4*)(Z + idx + 8);
        float ov[16], zv[16];
#pragma unroll
        for (int e = 0; e < 4; ++e) { ov[2 * e] = bf2f(o0[e] & 0xffff); ov[2 * e + 1] = bf2f(o0[e] >> 16); ov[8 + 2 * e] = bf2f(o1[e] & 0xffff); ov[8 + 2 * e + 1] = bf2f(o1[e] >> 16);
            zv[2 * e] = bf2f(z0[e] & 0xffff); zv[2 * e + 1] = bf2f(z0[e] >> 16); zv[8 + 2 * e] = bf2f(z1[e] & 0xffff); zv[8 + 2 * e + 1] = bf2f(z1[e] >> 16); }
        float ss = 0.f;
#pragma unroll
        for (int e = 0; e < 16; ++e) ss += ov[e] * ov[e];
        ss += shx(ss, 1, C.lane); ss += shx(ss, 2, C.lane); ss += shx(ss, 4, C.lane);
        const float rms = 1.f / sqrtf(ss * (1.f / 128.f) + RMS_EPS);
        unsigned w[8];
#pragma unroll
        for (int e = 0; e < 8; ++e) { const float a = ov[2 * e] * rms * nw[2 * e] * siluf(zv[2 * e]), c = ov[2 * e + 1] * rms * nw[2 * e + 1] * siluf(zv[2 * e + 1]); w[e] = pk2(a, c); }
        *(u32x4*)(GO + idx) = (u32x4){w[0], w[1], w[2], w[3]}; *(u32x4*)(GO + idx + 8) = (u32x4){w[4], w[5], w[6], w[7]};
    }
}

constexpr int PL_RAW = 0, PL_XS = 0, PL_IM = 33792, PL_QS = 51456, PL_KS = 68864, PL_VS = 86272, PL_LM = 103680, PL_SC = 121088, PL_CW = 122880;
constexpr int QS_LD = 136, XS_LD = 264, LM_LD = 68, IM_LD = 72;
__device__ __forceinline__ int sigma_idx(int kk, int quad, int jj) { return 16 * (2 * kk + (jj >> 2)) + 4 * quad + (jj & 3); }
__device__ __forceinline__ void gdn_prep_unit(const Ctx& C, int l, int unit) {
    int tid = C.tid; asm volatile("" : "+v"(tid));
    const int lane = tid & 63, wave = C.wave;
    const int h = unit & 7, gc = unit >> 3, c = gc & 31;
    LAS unsigned char* lb = C.lds; asm volatile("" : "+v"(lb));
    LAS bf16* RAW = (LAS bf16*)(lb + PL_RAW);
    LAS bf16* XS = (LAS bf16*)(lb + PL_XS);
    LAS bf16* IM = (LAS bf16*)(lb + PL_IM);
    LAS bf16* QS = (LAS bf16*)(lb + PL_QS); LAS bf16* KS = (LAS bf16*)(lb + PL_KS); LAS bf16* VS = (LAS bf16*)(lb + PL_VS);
    LAS float* LM = (LAS float*)(lb + PL_LM);
    LAS float* SC = (LAS float*)(lb + PL_SC);
    LAS float* CW = (LAS float*)(lb + PL_CW);
    bf16* DQ = (bf16*)(C.ws + WS_DQ) + (size_t)unit * 8192; bf16* DK = (bf16*)(C.ws + WS_DK) + (size_t)unit * 8192; bf16* DV = (bf16*)(C.ws + WS_DV) + (size_t)unit * 8192;
    bf16* WG = (bf16*)(C.ws + WS_WG) + (size_t)unit * 8192; bf16* IG = (bf16*)(C.ws + WS_INTRA) + (size_t)unit * 4096;
    if (wave == 0) {
        const float* ba = (const float*)(C.ws + WS_BA) + (size_t)(gc * 64 + lane) * 16;
        const float braw = ba[h], araw = ba[8 + h];
        const float beta = sigm(braw); const float xx = araw + C.in[I_DTB][l * 8 + h];
        const float ex = __expf(-fabsf(xx)); const float sp = fmaxf(xx, 0.f) + (ex < 1e-3f ? ex * (1.f - 0.5f * ex) : __logf(1.f + ex));
        float g = -__expf(C.in[I_ALOG][l * 8 + h]) * sp;
#pragma unroll
        for (int o = 1; o < 64; o <<= 1) { const float t = shup(g, o, lane); if (lane >= o) g += t; }
        const float glast = __int_as_float(__builtin_amdgcn_readlane(__float_as_int(g), 63));
        SC[lane] = g; SC[64 + lane] = beta; SC[128 + lane] = __expf(g); SC[192 + lane] = __expf(glast - g);
        if (lane == 63) ((float*)(C.ws + WS_LAST))[unit] = __expf(g);
    }
    {
        f32x4 cwv = (f32x4){0.f, 0.f, 0.f, 0.f};
        if (tid < 384) { const int j = tid / 96, rem = tid % 96, tsr = rem >> 5, c4 = rem & 31; cwv = *(const f32x4*)(C.in[I_CONVW] + (size_t)l * 4 * 3072 + j * 3072 + tsr * 1024 + h * 128 + c4 * 4); }
#pragma unroll 1
        for (int id = tid; id < 3 * 67 * 16; id += 2 * NTHREADS) {
            const int id2 = id + NTHREADS; u32x4 v0 = (u32x4){0u, 0u, 0u, 0u}, v1 = v0;
            { const int tsr = id / (67 * 16), rem = id % (67 * 16), r = rem >> 4, ch = rem & 15;
              if (r >= 3) v0 = *(const u32x4*)((const bf16*)(C.ws + WS_DQ + (size_t)tsr * 32 * MiB) + (size_t)unit * 8192 + (r - 3) * 128 + ch * 8);
              else if (c > 0) v0 = *(const u32x4*)((const bf16*)(C.ws + WS_HALO) + ((size_t)(gc - 1) * 3 + r) * 3072 + tsr * 1024 + h * 128 + ch * 8); }
            if (id2 < 3 * 67 * 16) { const int tsr = id2 / (67 * 16), rem = id2 % (67 * 16), r = rem >> 4, ch = rem & 15;
              if (r >= 3) v1 = *(const u32x4*)((const bf16*)(C.ws + WS_DQ + (size_t)tsr * 32 * MiB) + (size_t)unit * 8192 + (r - 3) * 128 + ch * 8);
              else if (c > 0) v1 = *(const u32x4*)((const bf16*)(C.ws + WS_HALO) + ((size_t)(gc - 1) * 3 + r) * 3072 + tsr * 1024 + h * 128 + ch * 8); }
            *(LAS u32x4*)(RAW + id * 8) = v0;
            if (id2 < 3 * 67 * 16) *(LAS u32x4*)(RAW + id2 * 8) = v1;
        }
        if (tid < 384) *(LAS f32x4*)(CW + tid * 4) = cwv;
    }
    LDS_BAR();
    {
        const int row = tid >> 3, seg = tid & 7, ch0 = seg * 16;
        float val[3][16];
#pragma unroll
        for (int tsr = 0; tsr < 3; ++tsr) {
            const float* cw = C.in[I_CONVW] + (size_t)l * 4 * 3072 + tsr * 1024 + h * 128 + ch0;
#pragma unroll
            for (int e = 0; e < 16; ++e) val[tsr][e] = 0.f;
#pragma unroll
            for (int j = 0; j < 4; ++j) {
                const u32x4 r0 = *(const LAS u32x4*)(RAW + (tsr * 67 + row + j) * 128 + ch0), r1 = *(const LAS u32x4*)(RAW + (tsr * 67 + row + j) * 128 + ch0 + 8);
                const f32x4 w0 = *(const f32x4*)(cw + j * 3072), w1 = *(const f32x4*)(cw + j * 3072 + 4), w2 = *(const f32x4*)(cw + j * 3072 + 8), w3 = *(const f32x4*)(cw + j * 3072 + 12);
#pragma unroll
                for (int e = 0; e < 4; ++e) {
                    val[tsr][2 * e] += bf2f(r0[e] & 0xffff) * (e < 2 ? w0[2 * e] : w1[2 * e - 4]);
                    val[tsr][2 * e + 1] += bf2f(r0[e] >> 16) * (e < 2 ? w0[2 * e + 1] : w1[2 * e - 3]);
                    val[tsr][8 + 2 * e] += bf2f(r1[e] & 0xffff) * (e < 2 ? w2[2 * e] : w3[2 * e - 4]);
                    val[tsr][8 + 2 * e + 1] += bf2f(r1[e] >> 16) * (e < 2 ? w2[2 * e + 1] : w3[2 * e - 3]);
                }
            }
#pragma unroll
            for (int e = 0; e < 16; ++e) val[tsr][e] = siluf(val[tsr][e]);
        }
        float sq = 0.f, sk = 0.f;
#pragma unroll
        for (int e = 0; e < 16; ++e) { sq += val[0][e] * val[0][e]; sk += val[1][e] * val[1][e]; }
        sq += shx(sq, 1, lane); sq += shx(sq, 2, lane); sq += shx(sq, 4, lane);
        sk += shx(sk, 1, lane); sk += shx(sk, 2, lane); sk += shx(sk, 4, lane);
        const float rq = (1.f / sqrtf(sq + RMS_EPS)) * 0.08838834764831845f, rk = 1.f / sqrtf(sk + RMS_EPS);
        unsigned wq[8], wk[8], wv[8];
#pragma unroll
        for (int e = 0; e < 8; ++e) { wq[e] = pk2(val[0][2 * e] * rq, val[0][2 * e + 1] * rq); wk[e] = pk2(val[1][2 * e] * rk, val[1][2 * e + 1] * rk); wv[e] = pk2(val[2][2 * e], val[2][2 * e + 1]); }
        LDS_BAR();
        *(LAS u32x4*)(QS + row * QS_LD + ch0) = (u32x4){wq[0], wq[1], wq[2], wq[3]}; *(LAS u32x4*)(QS + row * QS_LD + ch0 + 8) = (u32x4){wq[4], wq[5], wq[6], wq[7]};
        *(LAS u32x4*)(KS + row * QS_LD + ch0) = (u32x4){wk[0], wk[1], wk[2], wk[3]}; *(LAS u32x4*)(KS + row * QS_LD + ch0 + 8) = (u32x4){wk[4], wk[5], wk[6], wk[7]};
        *(LAS u32x4*)(VS + row * QS_LD + ch0) = (u32x4){wv[0], wv[1], wv[2], wv[3]}; *(LAS u32x4*)(VS + row * QS_LD + ch0 + 8) = (u32x4){wv[4], wv[5], wv[6], wv[7]};
    }
    LDS_BAR();
    {
        const int mat = wave >> 2, mt = wave & 3, fr = lane & 15, quad = lane >> 4;
        LAS bf16* AS = mat ? QS : KS;
        bf16x8 af[4];
#pragma unroll
        for (int ks = 0; ks < 4; ++ks) af[ks] = *(const LAS bf16x8*)(AS + (16 * mt + fr) * QS_LD + 32 * ks + 8 * quad);
#pragma unroll
        for (int nt = 0; nt < 4; ++nt) {
            f32x4 a = (f32x4){0.f, 0.f, 0.f, 0.f};
#pragma unroll
            for (int ks = 0; ks < 4; ++ks) { const bf16x8 bfr = *(const LAS bf16x8*)(KS + (16 * nt + fr) * QS_LD + 32 * ks + 8 * quad); a = __builtin_amdgcn_mfma_f32_16x16x32_bf16(af[ks], bfr, a, 0, 0, 0); }
            const int j = 16 * nt + fr; const float gj = SC[j];
            f32x4 lt4;
#pragma unroll
            for (int e = 0; e < 4; ++e) {
                const int i = 16 * mt + 4 * quad + e; const float gi = SC[i];
                const float dec = __expf(fminf(gi - gj, 0.f));
                if (mat == 0) lt4[e] = (i > j) ? SC[64 + i] * a[e] * dec : 0.f;
                else IM[i * IM_LD + j] = (bf16)(pk2((i >= j) ? a[e] * dec : 0.f, 0.f) & 0xffff);
            }
            if (mat == 0) *(LAS f32x4*)(LM + j * LM_LD + 16 * mt + 4 * quad) = lt4;
        }
    }
    LDS_BAR();
    if (tid < 256) {
        float x[64];
        const bool isv = tid < 128; const int cc = isv ? tid : tid - 128;
#pragma unroll
        for (int i = 0; i < 64; ++i) { const float bt = SC[64 + i]; x[i] = isv ? bf2f(VS[i * QS_LD + cc]) * bt : bf2f(KS[i * QS_LD + cc]) * bt * SC[128 + i]; }
        typedef float f32x2s __attribute__((ext_vector_type(2)));
#pragma unroll
        for (int ib = 0; ib < 16; ++ib) {
            f32x2s s01 = {x[4 * ib], x[4 * ib + 1]}, s23 = {x[4 * ib + 2], x[4 * ib + 3]};
#pragma unroll
            for (int j = 0; j < 4 * ib; ++j) {
                const f32x4 lt = *(const LAS f32x4*)(LM + j * LM_LD + 4 * ib);
                const f32x2s xj = {x[j], x[j]}, la = {lt[0], lt[1]}, lb = {lt[2], lt[3]};
                s01 -= la * xj; s23 -= lb * xj;
            }
            const f32x4 l0 = *(const LAS f32x4*)(LM + (4 * ib + 0) * LM_LD + 4 * ib), l1 = *(const LAS f32x4*)(LM + (4 * ib + 1) * LM_LD + 4 * ib), l2 = *(const LAS f32x4*)(LM + (4 * ib + 2) * LM_LD + 4 * ib);
            const float x0 = s01[0];
            const float x1 = s01[1] - l0[1] * x0;
            const float x2 = s23[0] - l0[2] * x0 - l1[2] * x1;
            const float x3 = s23[1] - l0[3] * x0 - l1[3] * x1 - l2[3] * x2;
            x[4 * ib] = x0; x[4 * ib + 1] = x1; x[4 * ib + 2] = x2; x[4 * ib + 3] = x3;
            asm volatile("" ::: "memory");
        }
#pragma unroll
        for (int i = 0; i < 64; ++i) XS[i * XS_LD + tid] = (bf16)(pk2(x[i], 0.f) & 0xffff);
    } else {
        const int t2 = tid - 256;
#pragma unroll
        for (int n = 0; n < 4; ++n) { const int id = t2 + 256 * n, mt = id >> 8, ks = (id >> 6) & 3, ln = id & 63; const int row = 16 * mt + (ln & 15), col = 32 * ks + 8 * (ln >> 4);
            const u32x4 v = *(const LAS u32x4*)(QS + row * QS_LD + col); const float sc = SC[128 + row]; u32x4 w;
#pragma unroll
            for (int e = 0; e < 4; ++e) w[e] = pk2(bf2f(v[e] & 0xffff) * sc, bf2f(v[e] >> 16) * sc);
            *(u32x4*)(DQ + (size_t)id * 8) = w; }
#pragma unroll
        for (int n = 0; n < 4; ++n) { const int id = t2 + 256 * n, mtk = id >> 7, kk = (id >> 6) & 1, ln = id & 63; const int kcol = 16 * mtk + (ln & 15), quad = ln >> 4; float f[8];
#pragma unroll
            for (int jj = 0; jj < 8; ++jj) { const int i = sigma_idx(kk, quad, jj); f[jj] = bf2f(KS[i * QS_LD + kcol]) * SC[192 + i]; }
            *(u32x4*)(DK + (size_t)id * 8) = (u32x4){pk2(f[0], f[1]), pk2(f[2], f[3]), pk2(f[4], f[5]), pk2(f[6], f[7])}; }
#pragma unroll
        for (int n = 0; n < 2; ++n) { const int id = t2 + 256 * n, mt = id >> 7, kk = (id >> 6) & 1, ln = id & 63; const int row = 16 * mt + (ln & 15), quad = ln >> 4;
            const u32x2 a = *(const LAS u32x2*)(IM + row * IM_LD + 32 * kk + 4 * quad), b2 = *(const LAS u32x2*)(IM + row * IM_LD + 32 * kk + 16 + 4 * quad);
            *(u32x4*)(IG + (size_t)id * 8) = (u32x4){a.x, a.y, b2.x, b2.y}; }
    }
    LDS_BAR();
#pragma unroll
    for (int n = 0; n < 2; ++n) { const int id = tid + 512 * n, mt = id >> 8, ks = (id >> 6) & 3, ln = id & 63; const int row = 16 * mt + (ln & 15), col = 128 + 32 * ks + 8 * (ln >> 4);
        *(u32x4*)(WG + (size_t)id * 8) = *(const LAS u32x4*)(XS + row * XS_LD + col); }
#pragma unroll
    for (int n = 0; n < 4; ++n) { const int id = tid + 512 * n, vs = id >> 9, mt = (id >> 7) & 3, nt = (id >> 6) & 1, ln = id & 63; const int r0 = 16 * mt + 4 * (ln >> 4), col = 32 * vs + 16 * nt + (ln & 15);
        const unsigned a0 = XS[(r0 + 0) * XS_LD + col], a1 = XS[(r0 + 1) * XS_LD + col], a2 = XS[(r0 + 2) * XS_LD + col], a3 = XS[(r0 + 3) * XS_LD + col];
        *(u32x2*)(DV + (size_t)id * 4) = (u32x2){a0 | (a1 << 16), a2 | (a3 << 16)}; }
    LDS_BAR();
}

constexpr int SL_ST = 0, SL_VF = 16384, ST_LD = 136;
__device__ __forceinline__ void gdn_scan_unit(const Ctx& C, int su) {
    const int lane = C.lane, wave = C.wave, fr = lane & 15, quad = lane >> 4;
    const int bh = su >> 2, vs = su & 3, b = bh >> 3, h = bh & 7;
    LAS bf16* ST = (LAS bf16*)(C.lds + SL_ST);
    LAS u32x4* VF = (LAS u32x4*)(C.lds + SL_VF);
    for (int i = C.tid; i < 32 * ST_LD / 2; i += NTHREADS) ((LAS unsigned*)ST)[i] = 0u;
    f32x4 sacc[2]; sacc[0] = (f32x4){0.f, 0.f, 0.f, 0.f}; sacc[1] = sacc[0];
    const bool isw = wave < 4; const int x = wave & 3, xp = x >> 1, nt = x & 1;
    bf16* OR = (bf16*)(C.ws + WS_OR);
    __syncthreads();
    bf16x8 af[2][4], kf[2], ifr[2][2]; u32x2 uf[2]; float last;
    bf16x8 naf[2][4], nkf[2], nifr[2][2]; u32x2 nuf[2]; float nlast;
#define SCAN_LOAD(AFv, KFv, IFv, UFv, LASTv, cc) do { \
        const size_t unit_ = (size_t)((b * 32 + (cc)) * 8 + h); \
        const bf16* AF_ = (const bf16*)(C.ws + (isw ? WS_WG : WS_DQ)) + unit_ * 8192; \
        const bf16* KF_ = (const bf16*)(C.ws + WS_DK) + unit_ * 8192; const bf16* UF_ = (const bf16*)(C.ws + WS_DV) + unit_ * 8192; const bf16* IG_ = (const bf16*)(C.ws + WS_INTRA) + unit_ * 4096; \
        LASTv = ((const float*)(C.ws + WS_LAST))[unit_]; \
        _Pragma("unroll") for (int mi = 0; mi < 2; ++mi) _Pragma("unroll") for (int ks = 0; ks < 4; ++ks) AFv[mi][ks] = *(const bf16x8*)(AF_ + (size_t)(((2 * xp + mi) * 4 + ks) * 64 + lane) * 8); \
        _Pragma("unroll") for (int kk = 0; kk < 2; ++kk) KFv[kk] = *(const bf16x8*)(KF_ + (size_t)((wave * 2 + kk) * 64 + lane) * 8); \
        if (isw) { _Pragma("unroll") for (int mi = 0; mi < 2; ++mi) UFv[mi] = *(const u32x2*)(UF_ + (size_t)(((vs * 4 + 2 * xp + mi) * 2 + nt) * 64 + lane) * 4); } \
        else { _Pragma("unroll") for (int mi = 0; mi < 2; ++mi) _Pragma("unroll") for (int kk = 0; kk < 2; ++kk) IFv[mi][kk] = *(const bf16x8*)(IG_ + (size_t)(((2 * xp + mi) * 2 + kk) * 64 + lane) * 8); } \
    } while (0)
    SCAN_LOAD(naf, nkf, nifr, nuf, nlast, 0);
    for (int c = 0; c < 32; ++c) {
#pragma unroll
        for (int mi = 0; mi < 2; ++mi) {
#pragma unroll
            for (int ks = 0; ks < 4; ++ks) af[mi][ks] = naf[mi][ks];
#pragma unroll
            for (int kk = 0; kk < 2; ++kk) ifr[mi][kk] = nifr[mi][kk];
            uf[mi] = nuf[mi]; }
        kf[0] = nkf[0]; kf[1] = nkf[1]; last = nlast;
        if (c + 1 < 32) SCAN_LOAD(naf, nkf, nifr, nuf, nlast, c + 1);
        bf16x8 sb[4];
#pragma unroll
        for (int ks = 0; ks < 4; ++ks) sb[ks] = *(const LAS bf16x8*)(ST + (16 * nt + fr) * ST_LD + 32 * ks + 8 * quad);
        f32x4 acc[2];
#pragma unroll
        for (int mi = 0; mi < 2; ++mi) { acc[mi] = (f32x4){0.f, 0.f, 0.f, 0.f};
#pragma unroll
            for (int ks = 0; ks < 4; ++ks) acc[mi] = __builtin_amdgcn_mfma_f32_16x16x32_bf16(af[mi][ks], sb[ks], acc[mi], 0, 0, 0); }
        if (isw) {
            float vn[8];
#pragma unroll
            for (int mi = 0; mi < 2; ++mi) { vn[4 * mi + 0] = bf2f(uf[mi].x & 0xffff) - acc[mi][0]; vn[4 * mi + 1] = bf2f(uf[mi].x >> 16) - acc[mi][1]; vn[4 * mi + 2] = bf2f(uf[mi].y & 0xffff) - acc[mi][2]; vn[4 * mi + 3] = bf2f(uf[mi].y >> 16) - acc[mi][3]; }
            VF[(xp * 2 + nt) * 64 + lane] = (u32x4){pk2(vn[0], vn[1]), pk2(vn[2], vn[3]), pk2(vn[4], vn[5]), pk2(vn[6], vn[7])};
        }
        LDS_WAIT(); __builtin_amdgcn_s_barrier(); asm volatile("" ::: "memory");
        bf16x8 vb[2][2];
#pragma unroll
        for (int kk = 0; kk < 2; ++kk)
#pragma unroll
            for (int n2 = 0; n2 < 2; ++n2) vb[kk][n2] = __builtin_bit_cast(bf16x8, VF[(kk * 2 + n2) * 64 + lane]);
        if (!isw) {
            bf16x8 vbo[2];
#pragma unroll
            for (int kk = 0; kk < 2; ++kk) vbo[kk] = __builtin_bit_cast(bf16x8, VF[(kk * 2 + nt) * 64 + lane]);
#pragma unroll
            for (int mi = 0; mi < 2; ++mi) {
#pragma unroll
                for (int kk = 0; kk < 2; ++kk) acc[mi] = __builtin_amdgcn_mfma_f32_16x16x32_bf16(ifr[mi][kk], vbo[kk], acc[mi], 0, 0, 0);
                bf16* op = OR + (size_t)(b * 2048 + c * 64 + 16 * (2 * xp + mi) + 4 * quad) * 1024 + h * 128 + 32 * vs + 16 * nt + fr;
#pragma unroll
                for (int e = 0; e < 4; ++e) op[(size_t)e * 1024] = (bf16)(pk2(acc[mi][e], 0.f) & 0xffff);
            }
        }
#pragma unroll
        for (int n2 = 0; n2 < 2; ++n2) {
            sacc[n2] = sacc[n2] * last;
#pragma unroll
            for (int kk = 0; kk < 2; ++kk) sacc[n2] = __builtin_amdgcn_mfma_f32_16x16x32_bf16(kf[kk], vb[kk][n2], sacc[n2], 0, 0, 0);
            *(LAS u32x2*)(ST + (16 * n2 + fr) * ST_LD + 16 * wave + 4 * quad) = (u32x2){pk2(sacc[n2][0], sacc[n2][1]), pk2(sacc[n2][2], sacc[n2][3])};
        }
        LDS_WAIT(); __builtin_amdgcn_s_barrier(); asm volatile("" ::: "memory");
    }
#undef SCAN_LOAD
}

struct Args { const float* in[21]; float* out; unsigned char* ws; int ph_lo, ph_hi; };
constexpr int PH_PER_LAYER = (REP_SP == 100) ? 12 : (REP_SP >= 0) ? 11 : 10, N_PHASES = 2 + NLAYER * PH_PER_LAYER;

__global__ void __launch_bounds__(NTHREADS, 2) mega_fwd(Args args) {
    extern __shared__ __attribute__((aligned(16))) unsigned char lds_raw[];
    Ctx C;
#pragma unroll
    for (int i = 0; i < 21; ++i) C.in[i] = args.in[i];
    C.out = args.out; C.ws = args.ws; C.lds = (LAS unsigned char*)lds_raw;
    C.G = gridDim.x; C.bid = blockIdx.x;
    cg::grid_group grid = cg::this_grid();
    volatile LAS unsigned* misc = (volatile LAS unsigned*)(C.lds + LDS_MISC);
    if (threadIdx.x < 4) misc[threadIdx.x] = 0u;
    __syncthreads();
    XcdBarrier xbar = xcd_barrier_post((unsigned*)(C.ws + WS_BAR), misc);
    for (int ph = args.ph_lo; ph < args.ph_hi; ++ph) {
        if (ph > args.ph_lo) { if (ph == 1) grid.sync(); else { XcdBarrier xb2 = xbar; asm volatile("" : "+s"(xb2.bar)); xcd_barrier(xb2); } }
        {
            typedef __attribute__((address_space(4))) const unsigned char* kptr_t;
            kptr_t kp = (kptr_t)__builtin_amdgcn_kernarg_segment_ptr(); asm volatile("" : "+s"(kp));
#pragma unroll
            for (int i = 0; i < 21; ++i) C.in[i] = *(const float* const __attribute__((address_space(4)))*)(kp + 8 * i);
            C.out = *(float* const __attribute__((address_space(4)))*)(kp + 168); C.ws = *(unsigned char* const __attribute__((address_space(4)))*)(kp + 176);
        }
        float* mod = (float*)(C.ws + WS_MOD);
        { int tid_ = threadIdx.x; asm volatile("" : "+v"(tid_)); C.tid = tid_; C.lane = tid_ & 63; C.wave = __builtin_amdgcn_readfirstlane(tid_ >> 6); }
        if (ph == 0) { phase_mod(C); phase_convert(C, 0); continue; }
        if (ph == 1) { phase_modulate(C, C.in[I_X], mod, 0, 1024, (bf16*)(C.ws + WS_A)); continue; }
        const int l = (ph - 2) / PH_PER_LAYER; int sp = (ph - 2) % PH_PER_LAYER; if (REP_SP == 100) { if (sp >= 2) sp -= 2; } else if (REP_SP >= 0 && sp > REP_SP) --sp;
        const float* modl = mod + (size_t)l * 8 * 6144;
        const float* Xres = (l == 0 && sp < 6) ? C.in[I_X] : C.out;
        switch (sp) {
#if PHM & 1
        case 0: {
            pg8::Gemm g{(const bf16*)(C.ws + WS_A), (const bf16*)(C.ws + WS_WIN), T_TOK, NPROJ, 1024}; pg8::StaticOrder S; S.init(T_TOK, NPROJ, C.G, C.bid);
            EpiProj E{C.ws}; pg8::gemm_phase<EpiProj, pg8::StaticOrder, true, true>(C.lds, g, S, E);
        } break;
#endif
#if PHM & 2
        case 1: { for (int u = C.bid; u < 2048; u += C.G) gdn_prep_unit(C, l, u); } break;
#endif
#if PHM & 4
        case 2: { for (int u = C.bid; u < 256; u += C.G) { const int su = (C.G == 256) ? (((u & 7) * 8 + (u >> 5)) * 4 + ((u >> 3) & 3)) : u; gdn_scan_unit(C, su); } } break;
#endif
#if PHM & 8
        case 3: { phase_attn_post(C, l); } break;
#endif
#if PHM & 16
        case 4: {
            pg8::StaticOrder S; S.init(T_TOK, 1024, C.G, C.bid);
            { pg8::Gemm g{(const bf16*)(C.ws + WS_A), (const bf16*)(C.ws + WS_WOA), T_TOK, 1024, 1024}; EpiGate<true> E{(const bf16*)(C.ws + WS_GA), (bf16*)(C.ws + WS_MP)};
              pg8::gemm_phase<EpiGate<true>, pg8::StaticOrder, true, true>(C.lds, g, S, E); }
            { pg8::Gemm g{(const bf16*)(C.ws + WS_GO), (const bf16*)(C.ws + WS_WOB), T_TOK, 1024, 1024}; EpiGate<false> E{(const bf16*)(C.ws + WS_GB), (bf16*)(C.ws + WS_MP)};
              pg8::gemm_phase<EpiGate<false>, pg8::StaticOrder, true, true>(C.lds, g, S, E); }
        } break;
#endif
#if PHM & 32
        case 5: {
            pg8::Gemm g{(const bf16*)(C.ws + WS_MP), (const bf16*)(C.ws + WS_WOUT), T_TOK, 1024, 1024}; pg8::StaticOrder S; S.init(T_TOK, 1024, C.G, C.bid);
            EpiResid E{Xres, (float*)(C.ws + WS_Y), modl + 2048, nullptr}; pg8::gemm_phase<EpiResid, pg8::StaticOrder, true, true>(C.lds, g, S, E);
        } break;
#endif
#if PHM & 64
        case 6: { phase_ln(C, (const float*)(C.ws + WS_Y), C.out, C.in[I_LN1G] + l * 1024, C.in[I_LN1B] + l * 1024, modl, 3072, 4096, (bf16*)(C.ws + WS_A)); } break;
#endif
#if PHM & 128
        case 7: {
            pg8::Gemm g{(const bf16*)(C.ws + WS_A), (const bf16*)(C.ws + WS_WFF1), T_TOK, DFF, 1024}; pg8::StaticOrder S; S.init(T_TOK, DFF, C.G, C.bid);
            EpiFF1 E{(bf16*)(C.ws + WS_H), C.in[I_BFF1] + l * DFF}; pg8::gemm_phase<EpiFF1, pg8::StaticOrder, true, true>(C.lds, g, S, E);
        } break;
#endif
#if PHM & 256
        case 8: {
            pg8::Gemm g{(const bf16*)(C.ws + WS_H), (const bf16*)(C.ws + WS_WFF2), T_TOK, 1024, DFF}; pg8::StaticOrder S; S.init(T_TOK, 1024, C.G, C.bid);
            EpiResid E{C.out, (float*)(C.ws + WS_Y), modl + 5120, C.in[I_BFF2] + l * 1024}; pg8::gemm_phase<EpiResid, pg8::StaticOrder, true, true>(C.lds, g, S, E);
        } break;
#endif
#if PHM & 512
        case 9: {
            const bool more = (l + 1 < NLAYER);
            phase_ln(C, (const float*)(C.ws + WS_Y), C.out, C.in[I_LN2G] + l * 1024, C.in[I_LN2B] + l * 1024, modl + 8 * 6144, 0, 1024, more ? (bf16*)(C.ws + WS_A) : (bf16*)nullptr);
            if (more) phase_convert(C, l + 1);
        } break;
#endif
        }
    }
}

#ifndef PHM
#define PHM 1023
#endif
#ifndef MK_PER_PHASE
#define MK_PER_PHASE 0
#endif
extern "C" void kernel_launch(void* const* d_in, const int* in_sizes, int n_in, void* d_out, int out_size, void* d_ws, size_t ws_size, hipStream_t stream) {
    static int grid = 0;
    if (grid == 0) {
        if (n_in != 21 || out_size != T_TOK * DM || ws_size < WS_END) { fprintf(stderr, "kernel_launch: unexpected shapes (n_in %d out %d ws %zu)\n", n_in, out_size, ws_size); grid = -1; return; }
        int dev = 0, cus = 0, per_cu = 0;
        hipGetDevice(&dev); hipDeviceGetAttribute(&cus, hipDeviceAttributeMultiprocessorCount, dev);
        hipFuncSetAttribute((const void*)mega_fwd, hipFuncAttributeMaxDynamicSharedMemorySize, LDS_BYTES);
        hipOccupancyMaxActiveBlocksPerMultiprocessor(&per_cu, (const void*)mega_fwd, NTHREADS, LDS_BYTES);
        if (per_cu < 1) per_cu = 1;
        (void)hipGetLastError();
        grid = cus * per_cu; if (grid > 256) grid = 256;
    }
    if (grid < 0) return;
    Args a{};
    for (int i = 0; i < 21; ++i) a.in[i] = (const float*)d_in[i];
    a.out = (float*)d_out; a.ws = (unsigned char*)d_ws;
#if MK_PER_PHASE
    for (int ph = 0; ph < N_PHASES; ++ph) { a.ph_lo = ph; a.ph_hi = ph + 1; hipLaunchKernelGGL(mega_fwd, dim3(grid), dim3(NTHREADS), LDS_BYTES, stream, a); }
#else
    (void)hipMemsetAsync((unsigned char*)d_ws + WS_BAR, 0, WS_BAR_BYTES, stream);
    a.ph_lo = 0; a.ph_hi = N_PHASES;
    void* kargs[] = {&a};
    hipError_t e = hipLaunchCooperativeKernel((const void*)mega_fwd, dim3(grid), dim3(NTHREADS), kargs, LDS_BYTES, stream);
    if (e != hipSuccess) fprintf(stderr, "cooperative launch failed: %s (grid %d)\n", hipGetErrorString(e), grid);
#endif
}
```

```cpp
#include <hip/hip_runtime.h>
#include <hip/hip_cooperative_groups.h>
#include <cstdio>
#include <cstdint>
namespace cg = cooperative_groups;
namespace pg8 {
#define PG8_LAS __attribute__((address_space(3)))
typedef unsigned short bf16_t;
typedef short bf16x8 __attribute__((ext_vector_type(8)));
typedef float f32x4 __attribute__((ext_vector_type(4)));
typedef unsigned u32x4 __attribute__((ext_vector_type(4)));
constexpr int BM = 256, BK = 64, HALF = 128, HTB = HALF * BK * 2  , STAGE_BYTES = 8 * HTB, NXCD = 8, WGM = 8;

__host__ __device__ __forceinline__ int lds_byte(int r, int c) { const int st = (r >> 4) * 2 + (c >> 5), rr = r & 15, cc = c & 31, ob = rr * 64 + cc * 2; return st * 1024 + (ob ^ (((ob >> 9) & 1) << 5)); }
__host__ __device__ __forceinline__ void stage_rc(int b, int& R, int& C) { const int st = b / 1024, sb = b % 1024, swz = sb ^ (((sb >> 9) & 1) << 5); R = (st >> 1) * 16 + swz / 64; C = (st & 1) * 32 + (swz % 64) / 2; }
__host__ __device__ __forceinline__ int perm32(int rho) { const int n = rho >> 4, i = rho & 15; return 8 * (i >> 2) + 4 * n + (i & 3); }

struct Unit { int pm, pn; };
struct Gemm { const bf16_t* A; const bf16_t* Bt; int M, N, K; };

struct StaticOrder {
    int nM, nN, nwg, G, c;
    __host__ __device__ void init(int M, int N, int G_, int c_) { nM = M / BM; nN = N / BM; nwg = nM * nN; G = G_; c = c_; }
    __host__ __device__ bool next(int i, Unit& u) const {
        const long L = (long)i * G + c; if (L >= nwg) return false;
        int wgid = (int)L; { const int q = nwg / NXCD, r = nwg % NXCD, xcd = wgid % NXCD, off = wgid / NXCD; wgid = (xcd < r ? xcd * (q + 1) : r * (q + 1) + (xcd - r) * q) + off; }
        const int nig = WGM * nN, gid = wgid / nig, fm = gid * WGM, gsz = (nM - fm) < WGM ? (nM - fm) : WGM;
        u.pm = fm + ((wgid % nig) % gsz); u.pn = (wgid % nig) / gsz; return true;
    }
    __device__ __forceinline__ void a_ready(const Unit&) const {}
    __device__ __forceinline__ void done(const Unit&) const {}
};

__device__ __forceinline__ unsigned cvt_pk_bf16(float lo, float hi) { unsigned r; asm volatile("v_cvt_pk_bf16_f32 %0, %1, %2" : "=v"(r) : "v"(lo), "v"(hi)); return r; }
typedef float f32x2 __attribute__((ext_vector_type(2)));
template <class Epi, class Sched, bool ALIGN_EPI = false, bool SP2 = false>
__device__ __forceinline__ void gemm_phase(PG8_LAS unsigned char* lds, const Gemm g, const Sched& S, const Epi& E) {
    int tid = threadIdx.x; asm volatile("" : "+v"(tid)); const int wid = __builtin_amdgcn_readfirstlane(tid >> 6), lane = tid & 63, wr = wid >> 2, wc = wid & 3, fr = lane & 15, fq = lane >> 4;
    const int K = g.K, nt = K / BK;
    unsigned voffA[2], voffB[2];
#pragma unroll
    for (int i = 0; i < 2; ++i) { int R, C; stage_rc(tid * 16 + i * 8192, R, C); const int Rb = Epi::PERM ? ((R & ~31) + perm32(R & 31)) : R;
        voffA[i] = (unsigned)(R * K + C) * 2u; voffB[i] = (unsigned)(Rb * K + C) * 2u; }
    const size_t kstep = (size_t)(BK * 2);
    const size_t hstep = (size_t)HALF * K * 2;
    const size_t tstep = 2 * hstep;
    const unsigned ldsw = (unsigned)wid * 1024u;
    const int aoff = lds_byte(wr * 64 + fr, fq * 8), boff = lds_byte(wc * 32 + fr, fq * 8);
#define PG8_SA(b, h) (((b) * 2 + (h)) * HTB)
#define PG8_SB(b, h) ((4 + (b) * 2 + (h)) * HTB)
#define PG8_STAGE(bufoff, gbase, voff) do { _Pragma("unroll") for (int _i = 0; _i < 2; ++_i) \
        __builtin_amdgcn_global_load_lds((const unsigned*)((const char*)(gbase) + (voff)[_i]), (PG8_LAS unsigned*)(lds + (bufoff) + ldsw + _i * 8192), 16, 0, 0); } while (0)
#define PG8_LDA(dst, b, h) do { _Pragma("unroll") for (int m = 0; m < 4; ++m) _Pragma("unroll") for (int k = 0; k < 2; ++k) dst[m][k] = *(const PG8_LAS bf16x8*)(lds + PG8_SA(b, h) + aoff + m * 2048 + k * 1024); } while (0)
#define PG8_LDB(dst, b, h) do { _Pragma("unroll") for (int n = 0; n < 2; ++n) _Pragma("unroll") for (int k = 0; k < 2; ++k) dst[n][k] = *(const PG8_LAS bf16x8*)(lds + PG8_SB(b, h) + boff + n * 2048 + k * 1024); } while (0)
#define PG8_MMA(ai, bj, At, Bt) do { __builtin_amdgcn_s_setprio(1); _Pragma("unroll") for (int m = 0; m < 4; ++m) _Pragma("unroll") for (int n = 0; n < 2; ++n) _Pragma("unroll") for (int k = 0; k < 2; ++k) \
        acc[ai][bj][m][n] = __builtin_amdgcn_mfma_f32_16x16x32_bf16(Bt[n][k], At[m][k], acc[ai][bj][m][n], 0, 0, 0); __builtin_amdgcn_s_setprio(0); } while (0)
#define PG8_WAIT_V(n) asm volatile("s_waitcnt vmcnt(" #n ")" ::: "memory")
#define PG8_WAIT_L(n) asm volatile("s_waitcnt lgkmcnt(" #n ")" ::: "memory")
#define PG8_BAR __builtin_amdgcn_s_barrier()
#define PG8_SCHED __builtin_amdgcn_sched_barrier(0)
    Unit cur, nxt; int ui = 0;
    if (!S.next(0, cur)) return;
    f32x4 acc[2][2][4][2];
#pragma unroll
    for (int a = 0; a < 2; ++a)
#pragma unroll
        for (int b = 0; b < 2; ++b)
#pragma unroll
            for (int m = 0; m < 4; ++m)
#pragma unroll
                for (int n = 0; n < 2; ++n) acc[a][b][m][n] = (f32x4){0.f, 0.f, 0.f, 0.f};
    bf16x8 At[4][2], B0[2][2], B1[2][2];
    const char* cA = (const char*)g.A + (size_t)cur.pm * tstep; const char* cB = (const char*)g.Bt + (size_t)cur.pn * tstep;
    S.a_ready(cur);
    if constexpr (SP2) {
        PG8_STAGE(PG8_SB(0, 0), cB, voffB); PG8_STAGE(PG8_SB(0, 1), cB + hstep, voffB); PG8_STAGE(PG8_SA(0, 0), cA, voffA); PG8_STAGE(PG8_SA(0, 1), cA + hstep, voffA);
        if (wr == 1) PG8_BAR;
        PG8_WAIT_V(2); PG8_BAR;
        PG8_STAGE(PG8_SB(1, 0), cB + kstep, voffB); PG8_STAGE(PG8_SA(1, 0), cA + kstep, voffA); PG8_STAGE(PG8_SB(1, 1), cB + hstep + kstep, voffB);
        PG8_WAIT_V(6); PG8_BAR;
    } else {
        PG8_STAGE(PG8_SB(0, 0), cB, voffB); PG8_STAGE(PG8_SA(0, 0), cA, voffA); PG8_STAGE(PG8_SB(0, 1), cB + hstep, voffB); PG8_STAGE(PG8_SA(0, 1), cA + hstep, voffA);
        if (wr == 1) PG8_BAR;
        PG8_WAIT_V(4); PG8_BAR;
        PG8_STAGE(PG8_SB(1, 0), cB + kstep, voffB); PG8_STAGE(PG8_SA(1, 0), cA + kstep, voffA); PG8_STAGE(PG8_SB(1, 1), cB + hstep + kstep, voffB);
        PG8_WAIT_V(6); PG8_BAR;
    }
    for (;;) {
        const bool has_next = S.next(ui + 1, nxt);
        const char* nA = has_next ? (const char*)g.A + (size_t)nxt.pm * tstep : cA; const char* nB = has_next ? (const char*)g.Bt + (size_t)nxt.pn * tstep : cB;
        for (int t = 0; t < nt; t += 2) {
            const bool last = (t == nt - 2);
            const char* a1 = cA + (size_t)(t + 1) * kstep;
            const char* a2 = last ? nA : cA + (size_t)(t + 2) * kstep; const char* b2 = last ? nB : cB + (size_t)(t + 2) * kstep;
            const char* a3 = a2 + kstep; const char* b3 = b2 + kstep;
            if (last && has_next) S.a_ready(nxt);
            if constexpr (SP2) {
            PG8_LDB(B0, 0, 0); PG8_LDB(B1, 0, 1); PG8_SCHED; PG8_LDA(At, 0, 0); PG8_STAGE(PG8_SA(1, 1), a1 + hstep, voffA);
            PG8_WAIT_V(8); PG8_WAIT_L(0); PG8_BAR; PG8_MMA(0, 0, At, B0); PG8_MMA(0, 1, At, B1); PG8_BAR; PG8_SCHED;
            PG8_LDA(At, 0, 1); PG8_STAGE(PG8_SB(0, 0), b2, voffB); PG8_STAGE(PG8_SB(0, 1), b2 + hstep, voffB); PG8_STAGE(PG8_SA(0, 0), a2, voffA);
            PG8_WAIT_V(8); PG8_WAIT_L(0); PG8_BAR; PG8_MMA(1, 0, At, B0); PG8_MMA(1, 1, At, B1); PG8_BAR; PG8_SCHED;
            PG8_LDB(B0, 1, 0); PG8_LDB(B1, 1, 1); PG8_SCHED; PG8_LDA(At, 1, 0); PG8_STAGE(PG8_SA(0, 1), a2 + hstep, voffA);
            PG8_WAIT_V(8); PG8_WAIT_L(0); PG8_BAR; PG8_MMA(0, 0, At, B0); PG8_MMA(0, 1, At, B1); PG8_BAR; PG8_SCHED;
            PG8_LDA(At, 1, 1); PG8_STAGE(PG8_SB(1, 0), b3, voffB); PG8_STAGE(PG8_SB(1, 1), b3 + hstep, voffB); PG8_STAGE(PG8_SA(1, 0), a3, voffA);
            PG8_WAIT_V(8); PG8_WAIT_L(0); PG8_BAR; PG8_MMA(1, 0, At, B0); PG8_MMA(1, 1, At, B1); PG8_BAR; PG8_SCHED;
            } else {
            PG8_LDB(B0, 0, 0); PG8_SCHED; PG8_LDA(At, 0, 0); PG8_STAGE(PG8_SA(1, 1), a1 + hstep, voffA);
            PG8_WAIT_L(8); PG8_BAR; PG8_WAIT_L(0); PG8_MMA(0, 0, At, B0); PG8_BAR; PG8_SCHED;
            PG8_LDB(B1, 0, 1); PG8_STAGE(PG8_SB(0, 0), b2, voffB);
            PG8_BAR; PG8_WAIT_L(0); PG8_MMA(0, 1, At, B1); PG8_BAR;
            PG8_LDA(At, 0, 1); PG8_STAGE(PG8_SA(0, 0), a2, voffA);
            PG8_BAR; PG8_WAIT_L(0); PG8_MMA(1, 0, At, B0); PG8_BAR; PG8_SCHED;
            PG8_STAGE(PG8_SB(0, 1), b2 + hstep, voffB);
            PG8_WAIT_V(6); PG8_BAR; PG8_MMA(1, 1, At, B1); PG8_BAR;
            PG8_LDB(B0, 1, 0); PG8_SCHED; PG8_LDA(At, 1, 0); PG8_STAGE(PG8_SA(0, 1), a2 + hstep, voffA);
            PG8_WAIT_L(8); PG8_BAR; PG8_WAIT_L(0); PG8_MMA(0, 0, At, B0); PG8_BAR; PG8_SCHED;
            PG8_LDB(B1, 1, 1); PG8_STAGE(PG8_SB(1, 0), b3, voffB);
            PG8_BAR; PG8_WAIT_L(0); PG8_MMA(0, 1, At, B1); PG8_BAR;
            PG8_LDA(At, 1, 1); PG8_STAGE(PG8_SA(1, 0), a3, voffA);
            PG8_BAR; PG8_WAIT_L(0); PG8_MMA(1, 0, At, B0); PG8_BAR; PG8_SCHED;
            PG8_STAGE(PG8_SB(1, 1), b3 + hstep, voffB);
            PG8_WAIT_V(6); PG8_BAR; PG8_MMA(1, 1, At, B1); PG8_BAR;
            }
        }
        if constexpr (ALIGN_EPI) { if (wr == 0) PG8_BAR; }
        if constexpr (!Epi::AFTER_DRAIN) { E(acc, cur, wr, wc, fr, fq); S.done(cur); }
        if (!has_next) break;
#pragma unroll
        for (int a = 0; a < 2; ++a)
#pragma unroll
            for (int b = 0; b < 2; ++b)
#pragma unroll
                for (int m = 0; m < 4; ++m)
#pragma unroll
                    for (int n = 0; n < 2; ++n) acc[a][b][m][n] = (f32x4){0.f, 0.f, 0.f, 0.f};
        cur = nxt; cA = nA; cB = nB; ++ui;
        if constexpr (ALIGN_EPI) { if (wr == 1) PG8_BAR; }
    }
    PG8_WAIT_V(0);
    if constexpr (!ALIGN_EPI) { if (wr == 0) PG8_BAR; }
    PG8_BAR;
    if constexpr (Epi::AFTER_DRAIN) { E.fused(acc, cur, wr, wc, fr, fq, lds, wid, lane); S.done(cur); }
#undef PG8_SA
#undef PG8_SB
#undef PG8_STAGE
#undef PG8_LDA
#undef PG8_LDB
#undef PG8_MMA
#undef PG8_WAIT_V
#undef PG8_WAIT_L
#undef PG8_BAR
#undef PG8_SCHED
}
}

#ifndef PHM
#define PHM 1023
#endif
#ifndef REP_SP
#define REP_SP -1
#endif
#define LAS __attribute__((address_space(3)))
typedef unsigned short bf16;
typedef float f32x4 __attribute__((ext_vector_type(4)));
typedef float f32x16 __attribute__((ext_vector_type(16)));
typedef short bf16x8 __attribute__((ext_vector_type(8)));
typedef unsigned u32x4 __attribute__((ext_vector_type(4)));
typedef unsigned u32x2 __attribute__((ext_vector_type(2)));

constexpr int T_TOK = 16384, DM = 1024, SEQ = 2048, NLAYER = 4, DFF = 4096, NPROJ = 7936, DIN = 7696;
constexpr float ALPHA_DN = 1.6817928305074290f;
constexpr float LN_EPS = 1e-5f, RMS_EPS = 1e-6f;
constexpr int NTHREADS = 512;
constexpr int LDS_BYTES = 135424, LDS_MISC = 135168;

constexpr size_t MiB = (size_t)1 << 20;
constexpr size_t WS_MOD = 0, WS_BA = 1 * MiB, WS_HALO = 2 * MiB, WS_LAST = 7 * MiB, WS_BAR = 7 * MiB + 512 * 1024, WS_BAR_BYTES = 16384, WS_W = 8 * MiB;
constexpr size_t WS_WIN = WS_W, WS_WOA = WS_W + 16 * MiB, WS_WOB = WS_W + 18 * MiB, WS_WOUT = WS_W + 20 * MiB, WS_WFF1 = WS_W + 22 * MiB, WS_WFF2 = WS_W + 30 * MiB;
constexpr size_t WS_A = 46 * MiB, WS_GO = 78 * MiB, WS_WG = 110 * MiB, WS_INTRA = 142 * MiB, WS_OR = 158 * MiB, WS_PROJ = 190 * MiB;
constexpr size_t WS_Q = WS_PROJ, WS_K = WS_PROJ + 32 * MiB, WS_VT = WS_PROJ + 40 * MiB, WS_DQ = WS_PROJ + 48 * MiB, WS_DK = WS_PROJ + 80 * MiB, WS_DV = WS_PROJ + 112 * MiB;
constexpr size_t WS_Z = WS_PROJ + 144 * MiB, WS_GA = WS_PROJ + 176 * MiB, WS_GB = WS_PROJ + 208 * MiB, WS_END = WS_PROJ + 240 * MiB;
constexpr size_t WS_MP = WS_PROJ, WS_H = WS_PROJ, WS_Y = WS_PROJ + 128 * MiB;

__device__ __forceinline__ float bf2f(unsigned h) { return __uint_as_float(h << 16); }
typedef float f32x2_t __attribute__((ext_vector_type(2))); typedef __bf16 bf16x2_t __attribute__((ext_vector_type(2)));
__device__ __forceinline__ unsigned pk2(float lo, float hi) { f32x2_t v = {lo, hi}; bf16x2_t b = __builtin_convertvector(v, bf16x2_t); return __builtin_bit_cast(unsigned, b); }
__device__ __forceinline__ float sigm(float x) { return __builtin_amdgcn_rcpf(1.f + __expf(-x)); }
__device__ __forceinline__ float siluf(float x) { return x * __builtin_amdgcn_rcpf(1.f + __expf(-x)); }
#define LDS_WAIT() asm volatile("s_waitcnt lgkmcnt(0)" ::: "memory")
#define LDS_BAR() do { asm volatile("s_waitcnt lgkmcnt(0)" ::: "memory"); __builtin_amdgcn_s_barrier(); asm volatile("" ::: "memory"); } while (0)
__device__ __forceinline__ float shx(float v, int m, int lane) { return __int_as_float(__builtin_amdgcn_ds_bpermute((lane ^ m) << 2, __float_as_int(v))); }
__device__ __forceinline__ float shup(float v, int o, int lane) { return __int_as_float(__builtin_amdgcn_ds_bpermute((lane - o) << 2, __float_as_int(v))); }

#define XB_TMO      128
#define XB_XCNT(j)  (256  + 64 * (j))
#define XB_XSUB(j)  (1280 + 64 * (j))
#define XB_XGEN(j)  (2304 + 64 * (j))
#define XB_TOP      3328
#define XB_TOPGEN   3392
#define XCD_BAR_WORDS 3456
#define XB_SPIN_CAP (1u << 18)

__device__ __forceinline__ unsigned xb_ld(unsigned* p)              { return __hip_atomic_load(p, __ATOMIC_RELAXED, __HIP_MEMORY_SCOPE_AGENT); }
__device__ __forceinline__ unsigned xb_add(unsigned* p, unsigned v) { return __hip_atomic_fetch_add(p, v, __ATOMIC_RELAXED, __HIP_MEMORY_SCOPE_AGENT); }
__device__ __forceinline__ unsigned xb_xcc_id() { return (unsigned)__builtin_amdgcn_s_getreg((3 << 11) | 20) & 0xFu; }
#define XB_SPIN(cond, bar) do { unsigned _sp = 0; while (cond) { __builtin_amdgcn_s_sleep(1); \
    if ((++_sp & 255u) == 0u) { if (xb_ld(&(bar)[XB_TMO])) break; if (_sp > XB_SPIN_CAP) { atomicAdd(&(bar)[XB_TMO], 1u); break; } } } } while (0)

struct XcdBarrier {
    unsigned* bar; unsigned x;
    volatile LAS unsigned* st;
};

__device__ __forceinline__ XcdBarrier xcd_barrier_post(unsigned* bar, volatile LAS unsigned* st) {
    XcdBarrier b; b.bar = bar; b.x = xb_xcc_id(); b.st = st;
    if (threadIdx.x == 0) (void)xb_add(&bar[XB_XCNT(b.x)], 1u);
    return b;
}
__device__ __forceinline__ void xcd_barrier_complete(unsigned* bar, unsigned x, unsigned& nloc, unsigned& nx) {
    const unsigned G = gridDim.x * gridDim.y * gridDim.z;
    unsigned sum, cnt, mine, sp = 0u;
    for (;;) {
        sum = 0u; cnt = 0u; mine = 0u;
#pragma unroll
        for (unsigned j = 0; j < 16; ++j) { const unsigned c = xb_ld(&bar[XB_XCNT(j)]); sum += c; cnt += (c > 0u) ? 1u : 0u; mine = (j == x) ? c : mine; }
        if (sum == G) break;
        __builtin_amdgcn_s_sleep(1);
        if ((++sp & 255u) == 0u) { if (xb_ld(&bar[XB_TMO])) break; if (sp > XB_SPIN_CAP) { atomicAdd(&bar[XB_TMO], 1u); break; } }
    }
    nloc = mine > 0u ? mine : 1u; nx = cnt > 0u ? cnt : 1u;
}

__device__ __forceinline__ void xcd_barrier(const XcdBarrier& b) {
    asm volatile("s_waitcnt vmcnt(0)" ::: "memory");
    __syncthreads();
    if (threadIdx.x == 0) {
        unsigned* bar = b.bar;
        __builtin_amdgcn_s_waitcnt(0);
        unsigned nloc = b.st[0], nx = b.st[1];
        if (nloc == 0u) { xcd_barrier_complete(bar, b.x, nloc, nx); b.st[0] = nloc; b.st[1] = nx; }
        const unsigned old = xb_add(&bar[XB_XSUB(b.x)], 1u);
        const unsigned gen = old / nloc;
        if (old + 1u == (gen + 1u) * nloc) {
            __builtin_amdgcn_fence(__ATOMIC_RELEASE, "agent");
            asm volatile("s_waitcnt vmcnt(0)" ::: "memory");
            const unsigned og = xb_add(&bar[XB_TOP], 1u);
            const unsigned tg = og / nx;
            if (og + 1u == (tg + 1u) * nx) xb_add(&bar[XB_TOPGEN], 1u);
            else XB_SPIN(xb_ld(&bar[XB_TOPGEN]) == tg, bar);
            __builtin_amdgcn_fence(__ATOMIC_ACQUIRE, "agent");
            xb_add(&bar[XB_XGEN(b.x)], 1u);
            asm volatile("s_waitcnt vmcnt(0)" ::: "memory");
        } else {
            XB_SPIN(xb_ld(&bar[XB_XGEN(b.x)]) == gen, bar);
            __builtin_amdgcn_fence(__ATOMIC_ACQUIRE, "agent");
            asm volatile("s_waitcnt vmcnt(0)" ::: "memory");
        }
    }
    __syncthreads();
}

struct EpiProj {
    static constexpr bool PERM = true, AFTER_DRAIN = false;
    unsigned char* ws;
    __device__ __forceinline__ void operator()(const f32x4 (&acc)[2][2][4][2], const pg8::Unit& u, int wr, int wc, int fr, int fq) const {
        const int pn = u.pn; const int row0 = u.pm * 256 + wr * 64 + fr; const int cl0 = wc * 32 + 8 * fq;
#pragma unroll
        for (int ai = 0; ai < 2; ++ai)
#pragma unroll
            for (int m = 0; m < 4; ++m) {
                const int row = row0 + ai * 128 + m * 16;
#pragma unroll
                for (int bj = 0; bj < 2; ++bj) {
                    const int cl = cl0 + bj * 128; const f32x4 v0 = acc[ai][bj][m][0], v1 = acc[ai][bj][m][1];
                    u32x4 w; w.x = pk2(v0[0], v0[1]); w.y = pk2(v0[2], v0[3]); w.z = pk2(v1[0], v1[1]); w.w = pk2(v1[2], v1[3]);
                    if (pn < 4) { *(u32x4*)((bf16*)(ws + WS_Q) + (size_t)row * 1024 + pn * 256 + cl) = w; }
                    else if (pn == 4) { *(u32x4*)((bf16*)(ws + WS_K) + (size_t)row * 256 + cl) = w; }
                    else if (pn == 5) {
                        const int kvh = cl >> 6, d = cl & 63, b = row >> 11, s = row & 2047;
                        bf16* p = (bf16*)(ws + WS_VT) + ((size_t)((b * 4 + kvh) * 64 + d)) * 2048 + s;
                        p[0 * 2048] = (bf16)(w.x & 0xffff); p[1 * 2048] = (bf16)(w.x >> 16); p[2 * 2048] = (bf16)(w.y & 0xffff); p[3 * 2048] = (bf16)(w.y >> 16);
                        p[4 * 2048] = (bf16)(w.z & 0xffff); p[5 * 2048] = (bf16)(w.z >> 16); p[6 * 2048] = (bf16)(w.w & 0xffff); p[7 * 2048] = (bf16)(w.w >> 16);
                    }
                    else if (pn < 18) {
                        const int tsr = (pn - 6) >> 2, col = ((pn - 6) & 3) * 256 + cl, h = col >> 7, unit = (row >> 6) * 8 + h;
                        *(u32x4*)((bf16*)(ws + WS_DQ + (size_t)tsr * 32 * MiB) + (size_t)unit * 8192 + (row & 63) * 128 + (col & 127)) = w;
                        if ((row & 63) >= 61) *(u32x4*)((bf16*)(ws + WS_HALO) + ((size_t)(row >> 6) * 3 + ((row & 63) - 61)) * 3072 + tsr * 1024 + col) = w;
                    }
                    else if (pn < 30) {
                        const int tsr = (pn - 18) >> 2, col = ((pn - 18) & 3) * 256 + cl;
                        *(u32x4*)((bf16*)(ws + WS_Z + (size_t)tsr * 32 * MiB) + (size_t)row * 1024 + col) = w;
                    }
                    else if (cl < 16) { float* p = (float*)(ws + WS_BA) + (size_t)row * 16 + cl; *(f32x4*)p = v0; *(f32x4*)(p + 4) = v1; }
                }
            }
    }
};
template <bool FIRST> struct EpiGate {
    static constexpr bool PERM = true, AFTER_DRAIN = false;
    const bf16* G; bf16* MP;
    __device__ __forceinline__ void operator()(const f32x4 (&acc)[2][2][4][2], const pg8::Unit& u, int wr, int wc, int fr, int fq) const {
        const int row0 = u.pm * 256 + wr * 64 + fr; const int col0 = u.pn * 256 + wc * 32 + 8 * fq;
#pragma unroll
        for (int ai = 0; ai < 2; ++ai)
#pragma unroll
            for (int m = 0; m < 4; ++m) {
                const int row = row0 + ai * 128 + m * 16;
#pragma unroll
                for (int bj = 0; bj < 2; ++bj) {
                    const size_t idx = (size_t)row * 1024 + col0 + bj * 128; const f32x4 v0 = acc[ai][bj][m][0], v1 = acc[ai][bj][m][1];
                    const u32x4 g = *(const u32x4*)(G + idx);
                    float r[8];
                    r[0] = sigm(bf2f(g.x & 0xffff)) * v0[0]; r[1] = sigm(bf2f(g.x >> 16)) * v0[1]; r[2] = sigm(bf2f(g.y & 0xffff)) * v0[2]; r[3] = sigm(bf2f(g.y >> 16)) * v0[3];
                    r[4] = sigm(bf2f(g.z & 0xffff)) * v1[0]; r[5] = sigm(bf2f(g.z >> 16)) * v1[1]; r[6] = sigm(bf2f(g.w & 0xffff)) * v1[2]; r[7] = sigm(bf2f(g.w >> 16)) * v1[3];
                    if (!FIRST) { const u32x4 p = *(const u32x4*)(MP + idx);
                        r[0] += bf2f(p.x & 0xffff); r[1] += bf2f(p.x >> 16); r[2] += bf2f(p.y & 0xffff); r[3] += bf2f(p.y >> 16);
                        r[4] += bf2f(p.z & 0xffff); r[5] += bf2f(p.z >> 16); r[6] += bf2f(p.w & 0xffff); r[7] += bf2f(p.w >> 16); }
                    u32x4 w; w.x = pk2(r[0], r[1]); w.y = pk2(r[2], r[3]); w.z = pk2(r[4], r[5]); w.w = pk2(r[6], r[7]);
                    *(u32x4*)(MP + idx) = w;
                }
            }
    }
};
struct EpiResid {
    static constexpr bool PERM = true, AFTER_DRAIN = false;
    const float* X; float* Y; const float* gt; const float* bias;
    __device__ __forceinline__ void operator()(const f32x4 (&acc)[2][2][4][2], const pg8::Unit& u, int wr, int wc, int fr, int fq) const {
        const int row0 = u.pm * 256 + wr * 64 + fr; const int col0 = u.pn * 256 + wc * 32 + 8 * fq; const int b = u.pm >> 3;
#pragma unroll
        for (int bj = 0; bj < 2; ++bj) {
            const int col = col0 + bj * 128;
            f32x4 g0 = *(const f32x4*)(gt + b * 6144 + col) + 1.0f, g1 = *(const f32x4*)(gt + b * 6144 + col + 4) + 1.0f;
            f32x4 b0 = (f32x4){0.f, 0.f, 0.f, 0.f}, b1 = b0; if (bias) { b0 = *(const f32x4*)(bias + col); b1 = *(const f32x4*)(bias + col + 4); }
#pragma unroll
            for (int ai = 0; ai < 2; ++ai)
#pragma unroll
                for (int m = 0; m < 4; ++m) {
                    const size_t idx = (size_t)(row0 + ai * 128 + m * 16) * 1024 + col;
                    const f32x4 x0 = *(const f32x4*)(X + idx), x1 = *(const f32x4*)(X + idx + 4);
                    *(f32x4*)(Y + idx) = x0 * ALPHA_DN + g0 * (acc[ai][bj][m][0] + b0);
                    *(f32x4*)(Y + idx + 4) = x1 * ALPHA_DN + g1 * (acc[ai][bj][m][1] + b1);
                }
        }
    }
};
struct EpiFF1 {
    static constexpr bool PERM = true, AFTER_DRAIN = false;
    bf16* H; const float* bias;
    __device__ __forceinline__ void operator()(const f32x4 (&acc)[2][2][4][2], const pg8::Unit& u, int wr, int wc, int fr, int fq) const {
        const int row0 = u.pm * 256 + wr * 64 + fr; const int col0 = u.pn * 256 + wc * 32 + 8 * fq;
#pragma unroll
        for (int bj = 0; bj < 2; ++bj) {
            const int col = col0 + bj * 128;
            const f32x4 b0 = *(const f32x4*)(bias + col), b1 = *(const f32x4*)(bias + col + 4);
#pragma unroll
            for (int ai = 0; ai < 2; ++ai)
#pragma unroll
                for (int m = 0; m < 4; ++m) {
                    f32x4 v0 = acc[ai][bj][m][0] + b0, v1 = acc[ai][bj][m][1] + b1;
#pragma unroll
                    for (int e = 0; e < 4; ++e) { v0[e] = fmaxf(v0[e], 0.f); v0[e] *= v0[e]; v1[e] = fmaxf(v1[e], 0.f); v1[e] *= v1[e]; }
                    u32x4 w; w.x = pk2(v0[0], v0[1]); w.y = pk2(v0[2], v0[3]); w.z = pk2(v1[0], v1[1]); w.w = pk2(v1[2], v1[3]);
                    *(u32x4*)(H + (size_t)(row0 + ai * 128 + m * 16) * 4096 + col) = w;
                }
        }
    }
};

struct Ctx {
    const float* in[21]; float* out; unsigned char* ws;
    LAS unsigned char* lds; int tid, lane, wave, G, bid;
};
enum { I_X = 0, I_C, I_WADA, I_BADA, I_WIN, I_CONVW, I_ALOG, I_DTB, I_SINKS, I_DNW, I_WOA, I_WOB, I_WOUT, I_LN1G, I_LN1B, I_WFF1, I_BFF1, I_WFF2, I_BFF2, I_LN2G, I_LN2B };

__device__ __forceinline__ void phase_mod(const Ctx& C) {
    LAS float* cact = (LAS float*)C.lds;
    LAS float* red = (LAS float*)(C.lds + 32768);
    for (int i = C.tid; i < 8192; i += NTHREADS) cact[i] = siluf(C.in[I_C][i]);
    __syncthreads();
    float* mod = (float*)(C.ws + WS_MOD);
    for (int unit = C.bid; unit < 384; unit += C.G) {
        const int l = unit / 96, n0 = (unit % 96) * 64;
        const float* W = C.in[I_WADA] + (size_t)l * 1024 * 6144 + n0 + C.lane;
        float a[8];
#pragma unroll
        for (int b = 0; b < 8; ++b) a[b] = 0.f;
        const int k0 = C.wave * 128;
#pragma unroll 16
        for (int k = k0; k < k0 + 128; ++k) { const float w = W[(size_t)k * 6144];
#pragma unroll
            for (int b = 0; b < 8; ++b) a[b] += cact[b * 1024 + k] * w; }
#pragma unroll
        for (int b = 0; b < 8; ++b) red[(C.wave * 8 + b) * 64 + C.lane] = a[b];
        __syncthreads();
        { const int b = C.tid >> 6, ln = C.tid & 63; float s = 0.f;
#pragma unroll
          for (int w = 0; w < 8; ++w) s += red[(w * 8 + b) * 64 + ln];
          mod[(size_t)(l * 8 + b) * 6144 + n0 + ln] = s + C.in[I_BADA][l * 6144 + n0 + ln]; }
        __syncthreads();
    }
}

__device__ __forceinline__ int win_src_col(int n) { return n < 5632 ? n : (n < 7680 ? n + 16 : (n < 7696 ? n - 7680 + 5632 : -1)); }
__device__ __forceinline__ void tr_item(const float* W, int K, int N, bf16* WT, LAS float* scr, int item, int nblk, int lane, bool winmap) {
    const int kb = item / nblk, nb = item % nblk, k0 = 64 * kb, n0 = 32 * nb;
    const int n4 = (lane & 7) * 4; const int sc = winmap ? win_src_col(n0 + n4) : n0 + n4;
    f32x4 v[8];
#pragma unroll
    for (int i = 0; i < 8; ++i) { const int kk = 8 * i + (lane >> 3); v[i] = (sc >= 0) ? *(const f32x4*)(W + (size_t)(k0 + kk) * N + sc) : (f32x4){0.f, 0.f, 0.f, 0.f}; }
#pragma unroll
    for (int i = 0; i < 8; ++i) { const int kk = 8 * i + (lane >> 3);
#pragma unroll
        for (int e = 0; e < 4; ++e) scr[kk * 33 + n4 + e] = v[i][e]; }
    LDS_WAIT();
    const int c = lane & 7;
#pragma unroll
    for (int j = 0; j < 4; ++j) { const int nn = (lane >> 3) + 8 * j; const LAS float* s = scr + (8 * c) * 33 + nn;
        u32x4 o; o.x = pk2(s[0 * 33], s[1 * 33]); o.y = pk2(s[2 * 33], s[3 * 33]); o.z = pk2(s[4 * 33], s[5 * 33]); o.w = pk2(s[6 * 33], s[7 * 33]);
        *(u32x4*)(WT + (size_t)(n0 + nn) * K + k0 + 8 * c) = o; }
    LDS_WAIT();
}
__device__ __forceinline__ void phase_convert(const Ctx& C, int l) {
    LAS float* scr = (LAS float*)(C.lds + 65536 + C.wave * 8704);
    const int gw = C.bid * 8 + C.wave, NGW = C.G * 8;
    constexpr int I_IN = 16 * 248, I_O = 16 * 32, I_1 = 16 * 128, I_2 = 64 * 32;
    constexpr int NIT = I_IN + 3 * I_O + I_1 + I_2;
    for (int it = gw; it < NIT; it += NGW) {
        int r = it;
        if (r < I_IN) { tr_item(C.in[I_WIN] + (size_t)l * 1024 * DIN, 1024, DIN, (bf16*)(C.ws + WS_WIN), scr, r, 248, C.lane, true); continue; } r -= I_IN;
        if (r < I_O) { tr_item(C.in[I_WOA] + (size_t)l * 1024 * 1024, 1024, 1024, (bf16*)(C.ws + WS_WOA), scr, r, 32, C.lane, false); continue; } r -= I_O;
        if (r < I_O) { tr_item(C.in[I_WOB] + (size_t)l * 1024 * 1024, 1024, 1024, (bf16*)(C.ws + WS_WOB), scr, r, 32, C.lane, false); continue; } r -= I_O;
        if (r < I_O) { tr_item(C.in[I_WOUT] + (size_t)l * 1024 * 1024, 1024, 1024, (bf16*)(C.ws + WS_WOUT), scr, r, 32, C.lane, false); continue; } r -= I_O;
        if (r < I_1) { tr_item(C.in[I_WFF1] + (size_t)l * 1024 * 4096, 1024, 4096, (bf16*)(C.ws + WS_WFF1), scr, r, 128, C.lane, false); continue; } r -= I_1;
        tr_item(C.in[I_WFF2] + (size_t)l * 4096 * 1024, 4096, 1024, (bf16*)(C.ws + WS_WFF2), scr, r, 32, C.lane, false);
    }
}

__device__ __forceinline__ float wave_sum(float v, int lane) {
#pragma unroll
    for (int o = 1; o < 64; o <<= 1) v += shx(v, o, lane);
    return v;
}
__device__ __forceinline__ void phase_modulate(const Ctx& C, const float* X, const float* modl  , int shoff, int scoff, bf16* U) {
    const int gw = C.bid * 8 + C.wave, NGW = C.G * 8;
    for (int row = gw; row < T_TOK; row += NGW) {
        const int b = row >> 11; const float* mb = modl + b * 6144;
#pragma unroll
        for (int j = 0; j < 4; ++j) { const int col = 4 * C.lane + 256 * j;
            const f32x4 x = *(const f32x4*)(X + (size_t)row * 1024 + col), sc = *(const f32x4*)(mb + scoff + col), sh = *(const f32x4*)(mb + shoff + col);
            const f32x4 u = x * (sc + 1.0f) + sh; u32x2 w; w.x = pk2(u[0], u[1]); w.y = pk2(u[2], u[3]);
            *(u32x2*)(U + (size_t)row * 1024 + col) = w; }
    }
}
__device__ __forceinline__ void phase_ln(const Ctx& C, const float* Y, float* X, const float* g, const float* bta, const float* modn, int shoff, int scoff, bf16* U) {
    const int gw = C.bid * 8 + C.wave, NGW = C.G * 8;
    for (int row0 = gw; row0 < T_TOK; row0 += 2 * NGW) {
        f32x4 v[2][4]; float s[2], s2[2], mean[2], rstd[2];
#pragma unroll
        for (int r = 0; r < 2; ++r) { const int row = row0 + r * NGW; s[r] = 0.f;
#pragma unroll
            for (int j = 0; j < 4; ++j) { v[r][j] = *(const f32x4*)(Y + (size_t)row * 1024 + 4 * C.lane + 256 * j); s[r] += (v[r][j][0] + v[r][j][1]) + (v[r][j][2] + v[r][j][3]); } }
#pragma unroll
        for (int r = 0; r < 2; ++r) { mean[r] = wave_sum(s[r], C.lane) * (1.f / 1024.f); s2[r] = 0.f;
#pragma unroll
            for (int j = 0; j < 4; ++j) { v[r][j] = v[r][j] - mean[r]; s2[r] += (v[r][j][0] * v[r][j][0] + v[r][j][1] * v[r][j][1]) + (v[r][j][2] * v[r][j][2] + v[r][j][3] * v[r][j][3]); } }
#pragma unroll
        for (int r = 0; r < 2; ++r) rstd[r] = 1.f / sqrtf(wave_sum(s2[r], C.lane) * (1.f / 1024.f) + LN_EPS);
#pragma unroll
        for (int r = 0; r < 2; ++r) { const int row = row0 + r * NGW; const int b = row >> 11;
#pragma unroll
            for (int j = 0; j < 4; ++j) { const int col = 4 * C.lane + 256 * j;
                const f32x4 x = v[r][j] * rstd[r] * *(const f32x4*)(g + col) + *(const f32x4*)(bta + col);
                *(f32x4*)(X + (size_t)row * 1024 + col) = x;
                if (U) { const float* mb = modn + b * 6144; const f32x4 sc = *(const f32x4*)(mb + scoff + col), sh = *(const f32x4*)(mb + shoff + col);
                    const f32x4 u = x * (sc + 1.0f) + sh; u32x2 w; w.x = pk2(u[0], u[1]); w.y = pk2(u[2], u[3]);
                    *(u32x2*)(U + (size_t)row * 1024 + col) = w; }
            } }
    }
}

__device__ __forceinline__ void attn_unit(const bf16* Q, const bf16* K, const bf16* VT, bf16* AO, float sink, int b, int h, int qt, int lane) {
    const int q = lane & 31, hi = lane >> 5, kvh = h >> 2, q0 = qt * 32;
    const bf16* qp = Q + (size_t)(b * 2048 + q0 + q) * 1024 + h * 64 + hi * 8;
    bf16x8 qf[4];
#pragma unroll
    for (int d0 = 0; d0 < 4; ++d0) qf[d0] = *(const bf16x8*)(qp + d0 * 16);
    const int pi = (q & 0x13) | ((q & 8) >> 1) | ((q & 4) << 1);
    const int jmin = (qt >= 4) ? 0 : (4 - qt);
    bf16x8 kf[5][4];
#pragma unroll
    for (int j = 0; j < 5; ++j) {
        const int kv0 = (j >= jmin) ? q0 - 128 + 32 * j : 0;
        const bf16* kp = K + (size_t)(b * 2048 + kv0 + pi) * 256 + kvh * 64 + hi * 8;
#pragma unroll
        for (int d0 = 0; d0 < 4; ++d0) kf[j][d0] = *(const bf16x8*)(kp + d0 * 16);
    }
    f32x16 s[5];
#pragma unroll
    for (int j = 0; j < 5; ++j) {
        f32x16 a;
#pragma unroll
        for (int r = 0; r < 16; ++r) a[r] = 0.f;
#pragma unroll
        for (int d0 = 0; d0 < 4; ++d0) a = __builtin_amdgcn_mfma_f32_32x32x16_bf16(kf[j][d0], qf[d0], a, 0, 0, 0);
        s[j] = a;
    }
    bf16x8 vf[5][2][2];
#pragma unroll
    for (int j = 0; j < 5; ++j) {
        const int kv0 = (j >= jmin) ? q0 - 128 + 32 * j : 0;
#pragma unroll
        for (int sl = 0; sl < 2; ++sl)
#pragma unroll
            for (int dh = 0; dh < 2; ++dh) vf[j][sl][dh] = *(const bf16x8*)(VT + ((size_t)((b * 4 + kvh) * 64 + 32 * dh + q)) * 2048 + kv0 + 16 * sl + 8 * hi);
    }
    float m = sink;
#pragma unroll
    for (int j = 0; j < 5; ++j)
#pragma unroll
        for (int r = 0; r < 16; ++r) {
            const int off = 16 * (r >> 3) + 8 * hi + (r & 7);
            bool valid = (j >= jmin);
            if (j == 0) valid = valid && (off > q);
            if (j == 4) valid = valid && (off <= q);
            const float v = valid ? s[j][r] * 0.125f : -INFINITY;
            s[j][r] = v; m = fmaxf(m, v);
        }
    m = fmaxf(m, shx(m, 32, lane));
    float sum = 0.f;
#pragma unroll
    for (int j = 0; j < 5; ++j)
#pragma unroll
        for (int r = 0; r < 16; ++r) { const float p = __expf(s[j][r] - m); s[j][r] = p; sum += p; }
    sum += shx(sum, 32, lane);
    const float inv = 1.f / (sum + __expf(sink - m));
    f32x16 o[2];
#pragma unroll
    for (int dh = 0; dh < 2; ++dh)
#pragma unroll
        for (int r = 0; r < 16; ++r) o[dh][r] = 0.f;
#pragma unroll
    for (int j = 0; j < 5; ++j) {
#pragma unroll
        for (int sl = 0; sl < 2; ++sl) {
            u32x4 pw; pw.x = pk2(s[j][8 * sl + 0] * inv, s[j][8 * sl + 1] * inv); pw.y = pk2(s[j][8 * sl + 2] * inv, s[j][8 * sl + 3] * inv);
            pw.z = pk2(s[j][8 * sl + 4] * inv, s[j][8 * sl + 5] * inv); pw.w = pk2(s[j][8 * sl + 6] * inv, s[j][8 * sl + 7] * inv);
            const bf16x8 pf = __builtin_bit_cast(bf16x8, pw);
#pragma unroll
            for (int dh = 0; dh < 2; ++dh) o[dh] = __builtin_amdgcn_mfma_f32_32x32x16_bf16(vf[j][sl][dh], pf, o[dh], 0, 0, 0);
        }
    }
    bf16* op = AO + (size_t)(b * 2048 + q0 + q) * 1024 + h * 64;
#pragma unroll
    for (int dh = 0; dh < 2; ++dh)
#pragma unroll
        for (int rr = 0; rr < 4; ++rr) { u32x2 w; w.x = pk2(o[dh][4 * rr + 0], o[dh][4 * rr + 1]); w.y = pk2(o[dh][4 * rr + 2], o[dh][4 * rr + 3]);
            *(u32x2*)(op + 32 * dh + 8 * rr + 4 * hi) = w; }
}
__device__ __forceinline__ void phase_attn_post(const Ctx& C, int l) {
    const int gw = C.bid * 8 + C.wave, NGW = C.G * 8;
    const bf16* Q = (const bf16*)(C.ws + WS_Q); const bf16* K = (const bf16*)(C.ws + WS_K); const bf16* VT = (const bf16*)(C.ws + WS_VT); bf16* AO = (bf16*)(C.ws + WS_A);
    for (int u = gw; u < 8192; u += NGW) {
        const int hg = u & 3, qt = (u >> 2) & 63, kvh = (u >> 8) & 3, b = u >> 10; const int h = kvh * 4 + hg;
        attn_unit(Q, K, VT, AO, C.in[I_SINKS][l * 16 + h], b, h, qt, C.lane);
    }
    const bf16* OR = (const bf16*)(C.ws + WS_OR); const bf16* Z = (const bf16*)(C.ws + WS_Z); bf16* GO = (bf16*)(C.ws + WS_GO);
    const float* nw = C.in[I_DNW] + l * 128 + (C.lane & 7) * 16;
    for (int row = gw; row < T_TOK; row += NGW) {
        const size_t idx = (size_t)row * 1024 + C.lane * 16;
        const u32x4 o0 = *(const u32x4*)(OR + idx), o1 = *(const u32x4*)(OR + idx + 8), z0 = *(const u32x4*)(Z + idx), z1 = *(const u32x4*)(Z + idx + 8);
        float ov[16], zv[16];
#pragma unroll
        for (int e = 0; e < 4; ++e) { ov[2 * e] = bf2f(o0[e] & 0xffff); ov[2 * e + 1] = bf2f(o0[e] >> 16); ov[8 + 2 * e] = bf2f(o1[e] & 0xffff); ov[8 + 2 * e + 1] = bf2f(o1[e] >> 16);
            zv[2 * e] = bf2f(z0[e] & 0xffff); zv[2 * e + 1] = bf2f(z0[e] >> 16); zv[8 + 2 * e] = bf2f(z1[e] & 0xffff); zv[8 + 2 * e + 1] = bf2f(z1[e] >> 16); }
        float ss = 0.f;
#pragma unroll
        for (int e = 0; e < 16; ++e) ss += ov[e] * ov[e];
        ss += shx(ss, 1, C.lane); ss += shx(ss, 2, C.lane); ss += shx(ss, 4, C.lane);
        const float rms = 1.f / sqrtf(ss * (1.f / 128.f) + RMS_EPS);
        unsigned w[8];
#pragma unroll
        for (int e = 0; e < 8; ++e) { const float a = ov[2 * e] * rms * nw[2 * e] * siluf(zv[2 * e]), c = ov[2 * e + 1] * rms * nw[2 * e + 1] * siluf(zv[2 * e + 1]); w[e] = pk2(a, c); }
        *(u32x4*)(GO + idx) = (u32x4){w[0], w[1], w[2], w[3]}; *(u32x4*)(GO + idx + 8) = (u32x4){w[4], w[5], w[6], w[7]};
    }
}

constexpr int PL_RAW = 0, PL_XS = 0, PL_IM = 33792, PL_QS = 51456, PL_KS = 68864, PL_VS = 86272, PL_LM = 103680, PL_SC = 121088, PL_CW = 122880;
constexpr int QS_LD = 136, XS_LD = 264, LM_LD = 68, IM_LD = 72;
__device__ __forceinline__ int sigma_idx(int kk, int quad, int jj) { return 16 * (2 * kk + (jj >> 2)) + 4 * quad + (jj & 3); }
__device__ __forceinline__ void gdn_prep_unit(const Ctx& C, int l, int unit) {
    int tid = C.tid; asm volatile("" : "+v"(tid));
    const int lane = tid & 63, wave = C.wave;
    const int h = unit & 7, gc = unit >> 3, c = gc & 31;
    LAS unsigned char* lb = C.lds; asm volatile("" : "+v"(lb));
    LAS bf16* RAW = (LAS bf16*)(lb + PL_RAW);
    LAS bf16* XS = (LAS bf16*)(lb + PL_XS);
    LAS bf16* IM = (LAS bf16*)(lb + PL_IM);
    LAS bf16* QS = (LAS bf16*)(lb + PL_QS); LAS bf16* KS = (LAS bf16*)(lb + PL_KS); LAS bf16* VS = (LAS bf16*)(lb + PL_VS);
    LAS float* LM = (LAS float*)(lb + PL_LM);
    LAS float* SC = (LAS float*)(lb + PL_SC);
    LAS float* CW = (LAS float*)(lb + PL_CW);
    bf16* DQ = (bf16*)(C.ws + WS_DQ) + (size_t)unit * 8192; bf16* DK = (bf16*)(C.ws + WS_DK) + (size_t)unit * 8192; bf16* DV = (bf16*)(C.ws + WS_DV) + (size_t)unit * 8192;
    bf16* WG = (bf16*)(C.ws + WS_WG) + (size_t)unit * 8192; bf16* IG = (bf16*)(C.ws + WS_INTRA) + (size_t)unit * 4096;
    if (wave == 0) {
        const float* ba = (const float*)(C.ws + WS_BA) + (size_t)(gc * 64 + lane) * 16;
        const float braw = ba[h], araw = ba[8 + h];
        const float beta = sigm(braw); const float xx = araw + C.in[I_DTB][l * 8 + h];
        const float ex = __expf(-fabsf(xx)); const float sp = fmaxf(xx, 0.f) + (ex < 1e-3f ? ex * (1.f - 0.5f * ex) : __logf(1.f + ex));
        float g = -__expf(C.in[I_ALOG][l * 8 + h]) * sp;
#pragma unroll
        for (int o = 1; o < 64; o <<= 1) { const float t = shup(g, o, lane); if (lane >= o) g += t; }
        const float glast = __int_as_float(__builtin_amdgcn_readlane(__float_as_int(g), 63));
        SC[lane] = g; SC[64 + lane] = beta; SC[128 + lane] = __expf(g); SC[192 + lane] = __expf(glast - g);
        if (lane == 63) ((float*)(C.ws + WS_LAST))[unit] = __expf(g);
    }
    {
        f32x4 cwv = (f32x4){0.f, 0.f, 0.f, 0.f};
        if (tid < 384) { const int j = tid / 96, rem = tid % 96, tsr = rem >> 5, c4 = rem & 31; cwv = *(const f32x4*)(C.in[I_CONVW] + (size_t)l * 4 * 3072 + j * 3072 + tsr * 1024 + h * 128 + c4 * 4); }
#pragma unroll 1
        for (int id = tid; id < 3 * 67 * 16; id += 2 * NTHREADS) {
            const int id2 = id + NTHREADS; u32x4 v0 = (u32x4){0u, 0u, 0u, 0u}, v1 = v0;
            { const int tsr = id / (67 * 16), rem = id % (67 * 16), r = rem >> 4, ch = rem & 15;
              if (r >= 3) v0 = *(const u32x4*)((const bf16*)(C.ws + WS_DQ + (size_t)tsr * 32 * MiB) + (size_t)unit * 8192 + (r - 3) * 128 + ch * 8);
              else if (c > 0) v0 = *(const u32x4*)((const bf16*)(C.ws + WS_HALO) + ((size_t)(gc - 1) * 3 + r) * 3072 + tsr * 1024 + h * 128 + ch * 8); }
            if (id2 < 3 * 67 * 16) { const int tsr = id2 / (67 * 16), rem = id2 % (67 * 16), r = rem >> 4, ch = rem & 15;
              if (r >= 3) v1 = *(const u32x4*)((const bf16*)(C.ws + WS_DQ + (size_t)tsr * 32 * MiB) + (size_t)unit * 8192 + (r - 3) * 128 + ch * 8);
              else if (c > 0) v1 = *(const u32x4*)((const bf16*)(C.ws + WS_HALO) + ((size_t)(gc - 1) * 3 + r) * 3072 + tsr * 1024 + h * 128 + ch * 8); }
            *(LAS u32x4*)(RAW + id * 8) = v0;
            if (id2 < 3 * 67 * 16) *(LAS u32x4*)(RAW + id2 * 8) = v1;
        }
        if (tid < 384) *(LAS f32x4*)(CW + tid * 4) = cwv;
    }
    LDS_BAR();
    {
        const int row = tid >> 3, seg = tid & 7, ch0 = seg * 16;
        float val[3][16];
#pragma unroll
        for (int tsr = 0; tsr < 3; ++tsr) {
            const float* cw = C.in[I_CONVW] + (size_t)l * 4 * 3072 + tsr * 1024 + h * 128 + ch0;
#pragma unroll
            for (int e = 0; e < 16; ++e) val[tsr][e] = 0.f;
#pragma unroll
            for (int j = 0; j < 4; ++j) {
                const u32x4 r0 = *(const LAS u32x4*)(RAW + (tsr * 67 + row + j) * 128 + ch0), r1 = *(const LAS u32x4*)(RAW + (tsr * 67 + row + j) * 128 + ch0 + 8);
                const f32x4 w0 = *(const f32x4*)(cw + j * 3072), w1 = *(const f32x4*)(cw + j * 3072 + 4), w2 = *(const f32x4*)(cw + j * 3072 + 8), w3 = *(const f32x4*)(cw + j * 3072 + 12);
#pragma unroll
                for (int e = 0; e < 4; ++e) {
                    val[tsr][2 * e] += bf2f(r0[e] & 0xffff) * (e < 2 ? w0[2 * e] : w1[2 * e - 4]);
                    val[tsr][2 * e + 1] += bf2f(r0[e] >> 16) * (e < 2 ? w0[2 * e + 1] : w1[2 * e - 3]);
                    val[tsr][8 + 2 * e] += bf2f(r1[e] & 0xffff) * (e < 2 ? w2[2 * e] : w3[2 * e - 4]);
                    val[tsr][8 + 2 * e + 1] += bf2f(r1[e] >> 16) * (e < 2 ? w2[2 * e + 1] : w3[2 * e - 3]);
                }
            }
#pragma unroll
            for (int e = 0; e < 16; ++e) val[tsr][e] = siluf(val[tsr][e]);
        }
        float sq = 0.f, sk = 0.f;
#pragma unroll
        for (int e = 0; e < 16; ++e) { sq += val[0][e] * val[0][e]; sk += val[1][e] * val[1][e]; }
        sq += shx(sq, 1, lane); sq += shx(sq, 2, lane); sq += shx(sq, 4, lane);
        sk += shx(sk, 1, lane); sk += shx(sk, 2, lane); sk += shx(sk, 4, lane);
        const float rq = (1.f / sqrtf(sq + RMS_EPS)) * 0.08838834764831845f, rk = 1.f / sqrtf(sk + RMS_EPS);
        unsigned wq[8], wk[8], wv[8];
#pragma unroll
        for (int e = 0; e < 8; ++e) { wq[e] = pk2(val[0][2 * e] * rq, val[0][2 * e + 1] * rq); wk[e] = pk2(val[1][2 * e] * rk, val[1][2 * e + 1] * rk); wv[e] = pk2(val[2][2 * e], val[2][2 * e + 1]); }
        LDS_BAR();
        *(LAS u32x4*)(QS + row * QS_LD + ch0) = (u32x4){wq[0], wq[1], wq[2], wq[3]}; *(LAS u32x4*)(QS + row * QS_LD + ch0 + 8) = (u32x4){wq[4], wq[5], wq[6], wq[7]};
        *(LAS u32x4*)(KS + row * QS_LD + ch0) = (u32x4){wk[0], wk[1], wk[2], wk[3]}; *(LAS u32x4*)(KS + row * QS_LD + ch0 + 8) = (u32x4){wk[4], wk[5], wk[6], wk[7]};
        *(LAS u32x4*)(VS + row * QS_LD + ch0) = (u32x4){wv[0], wv[1], wv[2], wv[3]}; *(LAS u32x4*)(VS + row * QS_LD + ch0 + 8) = (u32x4){wv[4], wv[5], wv[6], wv[7]};
    }
    LDS_BAR();
    {
        const int mat = wave >> 2, mt = wave & 3, fr = lane & 15, quad = lane >> 4;
        LAS bf16* AS = mat ? QS : KS;
        bf16x8 af[4];
#pragma unroll
        for (int ks = 0; ks < 4; ++ks) af[ks] = *(const LAS bf16x8*)(AS + (16 * mt + fr) * QS_LD + 32 * ks + 8 * quad);
#pragma unroll
        for (int nt = 0; nt < 4; ++nt) {
            f32x4 a = (f32x4){0.f, 0.f, 0.f, 0.f};
#pragma unroll
            for (int ks = 0; ks < 4; ++ks) { const bf16x8 bfr = *(const LAS bf16x8*)(KS + (16 * nt + fr) * QS_LD + 32 * ks + 8 * quad); a = __builtin_amdgcn_mfma_f32_16x16x32_bf16(af[ks], bfr, a, 0, 0, 0); }
            const int j = 16 * nt + fr; const float gj = SC[j];
            f32x4 lt4;
#pragma unroll
            for (int e = 0; e < 4; ++e) {
                const int i = 16 * mt + 4 * quad + e; const float gi = SC[i];
                const float dec = __expf(fminf(gi - gj, 0.f));
                if (mat == 0) lt4[e] = (i > j) ? SC[64 + i] * a[e] * dec : 0.f;
                else IM[i * IM_LD + j] = (bf16)(pk2((i >= j) ? a[e] * dec : 0.f, 0.f) & 0xffff);
            }
            if (mat == 0) *(LAS f32x4*)(LM + j * LM_LD + 16 * mt + 4 * quad) = lt4;
        }
    }
    LDS_BAR();
    if (tid < 256) {
        float x[64];
        const bool isv = tid < 128; const int cc = isv ? tid : tid - 128;
#pragma unroll
        for (int i = 0; i < 64; ++i) { const float bt = SC[64 + i]; x[i] = isv ? bf2f(VS[i * QS_LD + cc]) * bt : bf2f(KS[i * QS_LD + cc]) * bt * SC[128 + i]; }
        typedef float f32x2s __attribute__((ext_vector_type(2)));
#pragma unroll
        for (int ib = 0; ib < 16; ++ib) {
            f32x2s s01 = {x[4 * ib], x[4 * ib + 1]}, s23 = {x[4 * ib + 2], x[4 * ib + 3]};
#pragma unroll
            for (int j = 0; j < 4 * ib; ++j) {
                const f32x4 lt = *(const LAS f32x4*)(LM + j * LM_LD + 4 * ib);
                const f32x2s xj = {x[j], x[j]}, la = {lt[0], lt[1]}, lb = {lt[2], lt[3]};
                s01 -= la * xj; s23 -= lb * xj;
            }
            const f32x4 l0 = *(const LAS f32x4*)(LM + (4 * ib + 0) * LM_LD + 4 * ib), l1 = *(const LAS f32x4*)(LM + (4 * ib + 1) * LM_LD + 4 * ib), l2 = *(const LAS f32x4*)(LM + (4 * ib + 2) * LM_LD + 4 * ib);
            const float x0 = s01[0];
            const float x1 = s01[1] - l0[1] * x0;
            const float x2 = s23[0] - l0[2] * x0 - l1[2] * x1;
            const float x3 = s23[1] - l0[3] * x0 - l1[3] * x1 - l2[3] * x2;
            x[4 * ib] = x0; x[4 * ib + 1] = x1; x[4 * ib + 2] = x2; x[4 * ib + 3] = x3;
            asm volatile("" ::: "memory");
        }
#pragma unroll
        for (int i = 0; i < 64; ++i) XS[i * XS_LD + tid] = (bf16)(pk2(x[i], 0.f) & 0xffff);
    } else {
        const int t2 = tid - 256;
#pragma unroll
        for (int n = 0; n < 4; ++n) { const int id = t2 + 256 * n, mt = id >> 8, ks = (id >> 6) & 3, ln = id & 63; const int row = 16 * mt + (ln & 15), col = 32 * ks + 8 * (ln >> 4);
            const u32x4 v = *(const LAS u32x4*)(QS + row * QS_LD + col); const float sc = SC[128 + row]; u32x4 w;
#pragma unroll
            for (int e = 0; e < 4; ++e) w[e] = pk2(bf2f(v[e] & 0xffff) * sc, bf2f(v[e] >> 16) * sc);
            *(u32x4*)(DQ + (size_t)id * 8) = w; }
#pragma unroll
        for (int n = 0; n < 4; ++n) { const int id = t2 + 256 * n, mtk = id >> 7, kk = (id >> 6) & 1, ln = id & 63; const int kcol = 16 * mtk + (ln & 15), quad = ln >> 4; float f[8];
#pragma unroll
            for (int jj = 0; jj < 8; ++jj) { const int i = sigma_idx(kk, quad, jj); f[jj] = bf2f(KS[i * QS_LD + kcol]) * SC[192 + i]; }
            *(u32x4*)(DK + (size_t)id * 8) = (u32x4){pk2(f[0], f[1]), pk2(f[2], f[3]), pk2(f[4], f[5]), pk2(f[6], f[7])}; }
#pragma unroll
        for (int n = 0; n < 2; ++n) { const int id = t2 + 256 * n, mt = id >> 7, kk = (id >> 6) & 1, ln = id & 63; const int row = 16 * mt + (ln & 15), quad = ln >> 4;
            const u32x2 a = *(const LAS u32x2*)(IM + row * IM_LD + 32 * kk + 4 * quad), b2 = *(const LAS u32x2*)(IM + row * IM_LD + 32 * kk + 16 + 4 * quad);
            *(u32x4*)(IG + (size_t)id * 8) = (u32x4){a.x, a.y, b2.x, b2.y}; }
    }
    LDS_BAR();
#pragma unroll
    for (int n = 0; n < 2; ++n) { const int id = tid + 512 * n, mt = id >> 8, ks = (id >> 6) & 3, ln = id & 63; const int row = 16 * mt + (ln & 15), col = 128 + 32 * ks + 8 * (ln >> 4);
        *(u32x4*)(WG + (size_t)id * 8) = *(const LAS u32x4*)(XS + row * XS_LD + col); }
#pragma unroll
    for (int n = 0; n < 4; ++n) { const int id = tid + 512 * n, vs = id >> 9, mt = (id >> 7) & 3, nt = (id >> 6) & 1, ln = id & 63; const int r0 = 16 * mt + 4 * (ln >> 4), col = 32 * vs + 16 * nt + (ln & 15);
        const unsigned a0 = XS[(r0 + 0) * XS_LD + col], a1 = XS[(r0 + 1) * XS_LD + col], a2 = XS[(r0 + 2) * XS_LD + col], a3 = XS[(r0 + 3) * XS_LD + col];
        *(u32x2*)(DV + (size_t)id * 4) = (u32x2){a0 | (a1 << 16), a2 | (a3 << 16)}; }
    LDS_BAR();
}

constexpr int SL_ST = 0, SL_VF = 16384, ST_LD = 136;
__device__ __forceinline__ void gdn_scan_unit(const Ctx& C, int su) {
    const int lane = C.lane, wave = C.wave, fr = lane & 15, quad = lane >> 4;
    const int bh = su >> 2, vs = su & 3, b = bh >> 3, h = bh & 7;
    LAS bf16* ST = (LAS bf16*)(C.lds + SL_ST);
    LAS u32x4* VF = (LAS u32x4*)(C.lds + SL_VF);
    for (int i = C.tid; i < 32 * ST_LD / 2; i += NTHREADS) ((LAS unsigned*)ST)[i] = 0u;
    f32x4 sacc[2]; sacc[0] = (f32x4){0.f, 0.f, 0.f, 0.f}; sacc[1] = sacc[0];
    const bool isw = wave < 4; const int x = wave & 3, xp = x >> 1, nt = x & 1;
    bf16* OR = (bf16*)(C.ws + WS_OR);
    __syncthreads();
    bf16x8 af[2][4], kf[2], ifr[2][2]; u32x2 uf[2]; float last;
    bf16x8 naf[2][4], nkf[2], nifr[2][2]; u32x2 nuf[2]; float nlast;
#define SCAN_LOAD(AFv, KFv, IFv, UFv, LASTv, cc) do { \
        const size_t unit_ = (size_t)((b * 32 + (cc)) * 8 + h); \
        const bf16* AF_ = (const bf16*)(C.ws + (isw ? WS_WG : WS_DQ)) + unit_ * 8192; \
        const bf16* KF_ = (const bf16*)(C.ws + WS_DK) + unit_ * 8192; const bf16* UF_ = (const bf16*)(C.ws + WS_DV) + unit_ * 8192; const bf16* IG_ = (const bf16*)(C.ws + WS_INTRA) + unit_ * 4096; \
        LASTv = ((const float*)(C.ws + WS_LAST))[unit_]; \
        _Pragma("unroll") for (int mi = 0; mi < 2; ++mi) _Pragma("unroll") for (int ks = 0; ks < 4; ++ks) AFv[mi][ks] = *(const bf16x8*)(AF_ + (size_t)(((2 * xp + mi) * 4 + ks) * 64 + lane) * 8); \
        _Pragma("unroll") for (int kk = 0; kk < 2; ++kk) KFv[kk] = *(const bf16x8*)(KF_ + (size_t)((wave * 2 + kk) * 64 + lane) * 8); \
        if (isw) { _Pragma("unroll") for (int mi = 0; mi < 2; ++mi) UFv[mi] = *(const u32x2*)(UF_ + (size_t)(((vs * 4 + 2 * xp + mi) * 2 + nt) * 64 + lane) * 4); } \
        else { _Pragma("unroll") for (int mi = 0; mi < 2; ++mi) _Pragma("unroll") for (int kk = 0; kk < 2; ++kk) IFv[mi][kk] = *(const bf16x8*)(IG_ + (size_t)(((2 * xp + mi) * 2 + kk) * 64 + lane) * 8); } \
    } while (0)
    SCAN_LOAD(naf, nkf, nifr, nuf, nlast, 0);
    for (int c = 0; c < 32; ++c) {
#pragma unroll
        for (int mi = 0; mi < 2; ++mi) {
#pragma unroll
            for (int ks = 0; ks < 4; ++ks) af[mi][ks] = naf[mi][ks];
#pragma unroll
            for (int kk = 0; kk < 2; ++kk) ifr[mi][kk] = nifr[mi][kk];
            uf[mi] = nuf[mi]; }
        kf[0] = nkf[0]; kf[1] = nkf[1]; last = nlast;
        if (c + 1 < 32) SCAN_LOAD(naf, nkf, nifr, nuf, nlast, c + 1);
        bf16x8 sb[4];
#pragma unroll
        for (int ks = 0; ks < 4; ++ks) sb[ks] = *(const LAS bf16x8*)(ST + (16 * nt + fr) * ST_LD + 32 * ks + 8 * quad);
        f32x4 acc[2];
#pragma unroll
        for (int mi = 0; mi < 2; ++mi) { acc[mi] = (f32x4){0.f, 0.f, 0.f, 0.f};
#pragma unroll
            for (int ks = 0; ks < 4; ++ks) acc[mi] = __builtin_amdgcn_mfma_f32_16x16x32_bf16(af[mi][ks], sb[ks], acc[mi], 0, 0, 0); }
        if (isw) {
            float vn[8];
#pragma unroll
            for (int mi = 0; mi < 2; ++mi) { vn[4 * mi + 0] = bf2f(uf[mi].x & 0xffff) - acc[mi][0]; vn[4 * mi + 1] = bf2f(uf[mi].x >> 16) - acc[mi][1]; vn[4 * mi + 2] = bf2f(uf[mi].y & 0xffff) - acc[mi][2]; vn[4 * mi + 3] = bf2f(uf[mi].y >> 16) - acc[mi][3]; }
            VF[(xp * 2 + nt) * 64 + lane] = (u32x4){pk2(vn[0], vn[1]), pk2(vn[2], vn[3]), pk2(vn[4], vn[5]), pk2(vn[6], vn[7])};
        }
        LDS_WAIT(); __builtin_amdgcn_s_barrier(); asm volatile("" ::: "memory");
        bf16x8 vb[2][2];
#pragma unroll
        for (int kk = 0; kk < 2; ++kk)
#pragma unroll
            for (int n2 = 0; n2 < 2; ++n2) vb[kk][n2] = __builtin_bit_cast(bf16x8, VF[(kk * 2 + n2) * 64 + lane]);
        if (!isw) {
            bf16x8 vbo[2];
#pragma unroll
            for (int kk = 0; kk < 2; ++kk) vbo[kk] = __builtin_bit_cast(bf16x8, VF[(kk * 2 + nt) * 64 + lane]);
#pragma unroll
            for (int mi = 0; mi < 2; ++mi) {
#pragma unroll
                for (int kk = 0; kk < 2; ++kk) acc[mi] = __builtin_amdgcn_mfma_f32_16x16x32_bf16(ifr[mi][kk], vbo[kk], acc[mi], 0, 0, 0);
                bf16* op = OR + (size_t)(b * 2048 + c * 64 + 16 * (2 * xp + mi) + 4 * quad) * 1024 + h * 128 + 32 * vs + 16 * nt + fr;
#pragma unroll
                for (int e = 0; e < 4; ++e) op[(size_t)e * 1024] = (bf16)(pk2(acc[mi][e], 0.f) & 0xffff);
            }
        }
#pragma unroll
        for (int n2 = 0; n2 < 2; ++n2) {
            sacc[n2] = sacc[n2] * last;
#pragma unroll
            for (int kk = 0; kk < 2; ++kk) sacc[n2] = __builtin_amdgcn_mfma_f32_16x16x32_bf16(kf[kk], vb[kk][n2], sacc[n2], 0, 0, 0);
            *(LAS u32x2*)(ST + (16 * n2 + fr) * ST_LD + 16 * wave + 4 * quad) = (u32x2){pk2(sacc[n2][0], sacc[n2][1]), pk2(sacc[n2][2], sacc[n2][3])};
        }
        LDS_WAIT(); __builtin_amdgcn_s_barrier(); asm volatile("" ::: "memory");
    }
#undef SCAN_LOAD
}

struct Args { const float* in[21]; float* out; unsigned char* ws; int ph_lo, ph_hi; };
constexpr int PH_PER_LAYER = (REP_SP == 100) ? 12 : (REP_SP >= 0) ? 11 : 10, N_PHASES = 2 + NLAYER * PH_PER_LAYER;

__global__ void __launch_bounds__(NTHREADS, 2) mega_fwd(Args args) {
    extern __shared__ __attribute__((aligned(16))) unsigned char lds_raw[];
    Ctx C;
#pragma unroll
    for (int i = 0; i < 21; ++i) C.in[i] = args.in[i];
    C.out = args.out; C.ws = args.ws; C.lds = (LAS unsigned char*)lds_raw;
    C.G = gridDim.x; C.bid = blockIdx.x;
    cg::grid_group grid = cg::this_grid();
    volatile LAS unsigned* misc = (volatile LAS unsigned*)(C.lds + LDS_MISC);
    if (threadIdx.x < 4) misc[threadIdx.x] = 0u;
    __syncthreads();
    XcdBarrier xbar = xcd_barrier_post((unsigned*)(C.ws + WS_BAR), misc);
    for (int ph = args.ph_lo; ph < args.ph_hi; ++ph) {
        if (ph > args.ph_lo) { if (ph == 1) grid.sync(); else { XcdBarrier xb2 = xbar; asm volatile("" : "+s"(xb2.bar)); xcd_barrier(xb2); } }
        {
            typedef __attribute__((address_space(4))) const unsigned char* kptr_t;
            kptr_t kp = (kptr_t)__builtin_amdgcn_kernarg_segment_ptr(); asm volatile("" : "+s"(kp));
#pragma unroll
            for (int i = 0; i < 21; ++i) C.in[i] = *(const float* const __attribute__((address_space(4)))*)(kp + 8 * i);
            C.out = *(float* const __attribute__((address_space(4)))*)(kp + 168); C.ws = *(unsigned char* const __attribute__((address_space(4)))*)(kp + 176);
        }
        float* mod = (float*)(C.ws + WS_MOD);
        { int tid_ = threadIdx.x; asm volatile("" : "+v"(tid_)); C.tid = tid_; C.lane = tid_ & 63; C.wave = __builtin_amdgcn_readfirstlane(tid_ >> 6); }
        if (ph == 0) { phase_mod(C); phase_convert(C, 0); continue; }
        if (ph == 1) { phase_modulate(C, C.in[I_X], mod, 0, 1024, (bf16*)(C.ws + WS_A)); continue; }
        const int l = (ph - 2) / PH_PER_LAYER; int sp = (ph - 2) % PH_PER_LAYER; if (REP_SP == 100) { if (sp >= 2) sp -= 2; } else if (REP_SP >= 0 && sp > REP_SP) --sp;
        const float* modl = mod + (size_t)l * 8 * 6144;
        const float* Xres = (l == 0 && sp < 6) ? C.in[I_X] : C.out;
        switch (sp) {
#if PHM & 1
        case 0: {
            pg8::Gemm g{(const bf16*)(C.ws + WS_A), (const bf16*)(C.ws + WS_WIN), T_TOK, NPROJ, 1024}; pg8::StaticOrder S; S.init(T_TOK, NPROJ, C.G, C.bid);
            EpiProj E{C.ws}; pg8::gemm_phase<EpiProj, pg8::StaticOrder, true, true>(C.lds, g, S, E);
        } break;
#endif
#if PHM & 2
        case 1: { for (int u = C.bid; u < 2048; u += C.G) gdn_prep_unit(C, l, u); } break;
#endif
#if PHM & 4
        case 2: { for (int u = C.bid; u < 256; u += C.G) { const int su = (C.G == 256) ? (((u & 7) * 8 + (u >> 5)) * 4 + ((u >> 3) & 3)) : u; gdn_scan_unit(C, su); } } break;
#endif
#if PHM & 8
        case 3: { phase_attn_post(C, l); } break;
#endif
#if PHM & 16
        case 4: {
            pg8::StaticOrder S; S.init(T_TOK, 1024, C.G, C.bid);
            { pg8::Gemm g{(const bf16*)(C.ws + WS_A), (const bf16*)(C.ws + WS_WOA), T_TOK, 1024, 1024}; EpiGate<true> E{(const bf16*)(C.ws + WS_GA), (bf16*)(C.ws + WS_MP)};
              pg8::gemm_phase<EpiGate<true>, pg8::StaticOrder, true, true>(C.lds, g, S, E); }
            { pg8::Gemm g{(const bf16*)(C.ws + WS_GO), (const bf16*)(C.ws + WS_WOB), T_TOK, 1024, 1024}; EpiGate<false> E{(const bf16*)(C.ws + WS_GB), (bf16*)(C.ws + WS_MP)};
              pg8::gemm_phase<EpiGate<false>, pg8::StaticOrder, true, true>(C.lds, g, S, E); }
        } break;
#endif
#if PHM & 32
        case 5: {
            pg8::Gemm g{(const bf16*)(C.ws + WS_MP), (const bf16*)(C.ws + WS_WOUT), T_TOK, 1024, 1024}; pg8::StaticOrder S; S.init(T_TOK, 1024, C.G, C.bid);
            EpiResid E{Xres, (float*)(C.ws + WS_Y), modl + 2048, nullptr}; pg8::gemm_phase<EpiResid, pg8::StaticOrder, true, true>(C.lds, g, S, E);
        } break;
#endif
#if PHM & 64
        case 6: { phase_ln(C, (const float*)(C.ws + WS_Y), C.out, C.in[I_LN1G] + l * 1024, C.in[I_LN1B] + l * 1024, modl, 3072, 4096, (bf16*)(C.ws + WS_A)); } break;
#endif
#if PHM & 128
        case 7: {
            pg8::Gemm g{(const bf16*)(C.ws + WS_A), (const bf16*)(C.ws + WS_WFF1), T_TOK, DFF, 1024}; pg8::StaticOrder S; S.init(T_TOK, DFF, C.G, C.bid);
            EpiFF1 E{(bf16*)(C.ws + WS_H), C.in[I_BFF1] + l * DFF}; pg8::gemm_phase<EpiFF1, pg8::StaticOrder, true, true>(C.lds, g, S, E);
        } break;
#endif
#if PHM & 256
        case 8: {
            pg8::Gemm g{(const bf16*)(C.ws + WS_H), (const bf16*)(C.ws + WS_WFF2), T_TOK, 1024, DFF}; pg8::StaticOrder S; S.init(T_TOK, 1024, C.G, C.bid);
            EpiResid E{C.out, (float*)(C.ws + WS_Y), modl + 5120, C.in[I_BFF2] + l * 1024}; pg8::gemm_phase<EpiResid, pg8::StaticOrder, true, true>(C.lds, g, S, E);
        } break;
#endif
#if PHM & 512
        case 9: {
            const bool more = (l + 1 < NLAYER);
            phase_ln(C, (const float*)(C.ws + WS_Y), C.out, C.in[I_LN2G] + l * 1024, C.in[I_LN2B] + l * 1024, modl + 8 * 6144, 0, 1024, more ? (bf16*)(C.ws + WS_A) : (bf16*)nullptr);
            if (more) phase_convert(C, l + 1);
        } break;
#endif
        }
    }
}

#ifndef PHM
#define PHM 1023
#endif
#ifndef MK_PER_PHASE
#define MK_PER_PHASE 0
#endif
extern "C" void kernel_launch(void* const* d_in, const int* in_sizes, int n_in, void* d_out, int out_size, void* d_ws, size_t ws_size, hipStream_t stream) {
    static int grid = 0;
    if (grid == 0) {
        if (n_in != 21 || out_size != T_TOK * DM || ws_size < WS_END) { fprintf(stderr, "kernel_launch: unexpected shapes (n_in %d out %d ws %zu)\n", n_in, out_size, ws_size); grid = -1; return; }
        int dev = 0, cus = 0, per_cu = 0;
        hipGetDevice(&dev); hipDeviceGetAttribute(&cus, hipDeviceAttributeMultiprocessorCount, dev);
        hipFuncSetAttribute((const void*)mega_fwd, hipFuncAttributeMaxDynamicSharedMemorySize, LDS_BYTES);
        hipOccupancyMaxActiveBlocksPerMultiprocessor(&per_cu, (const void*)mega_fwd, NTHREADS, LDS_BYTES);
        if (per_cu < 1) per_cu = 1;
        (void)hipGetLastError();
        grid = cus * per_cu; if (grid > 256) grid = 256;
    }
    if (grid < 0) return;
    Args a{};
    for (int i = 0; i < 21; ++i) a.in[i] = (const float*)d_in[i];
    a.out = (float*)d_out; a.ws = (unsigned char*)d_ws;
#if MK_PER_PHASE
    for (int ph = 0; ph < N_PHASES; ++ph) { a.ph_lo = ph; a.ph_hi = ph + 1; hipLaunchKernelGGL(mega_fwd, dim3(grid), dim3(NTHREADS), LDS_BYTES, stream, a); }
#else
    (void)hipMemsetAsync((unsigned char*)d_ws + WS_BAR, 0, WS_BAR_BYTES, stream);
    a.ph_lo = 0; a.ph_hi = N_PHASES;
    void* kargs[] = {&a};
    hipError_t e = hipLaunchCooperativeKernel((const void*)mega_fwd, dim3(grid), dim3(NTHREADS), kargs, LDS_BYTES, stream);
    if (e != hipSuccess) fprintf(stderr, "cooperative launch failed: %s (grid %d)\n", hipGetErrorString(e), grid);
#endif
}
```
